# Optimizing an MI355X kernel written in HIP

```python
import math
import jax, jax.numpy as jnp
from jax import lax
import numpy as np

D_MODEL = 1024
BATCH = 1
SEQ = 16384
DEPTH = 2

N_A_LAYERS = DEPTH // 2
N_B_LAYERS = DEPTH - N_A_LAYERS
HEAD_DIM = 64
DIFF_HEADS = D_MODEL // (2 * HEAD_DIM)
MOBA_HEADS = D_MODEL // HEAD_DIM
D_FF = 2816
ROPE_THETA = 10000.0
MOBA_BLOCK = 256
MOBA_TOPK = 3
DIFF_Q_CHUNK = 128
MOBA_Q_CHUNK = 64
FFN_RESIDUAL_SCALE = 0.5
NORM_EPS = 1e-6

kernel_name = "yoco_diffattn_moba_macaron_sandwich"


def rms_norm(x, g):
    xf = x.astype(jnp.float32)
    y = xf * lax.rsqrt(jnp.mean(xf * xf, axis=-1, keepdims=True) + NORM_EPS)
    return (y * g.astype(jnp.float32)).astype(x.dtype)


def rope_tables(seq, dim):
    pos = jnp.arange(seq, dtype=jnp.float32)
    inv_freq = 1.0 / (ROPE_THETA ** (jnp.arange(0, dim, 2, dtype=jnp.float32) / dim))
    ang = pos[:, None] * inv_freq[None, :]
    ang = jnp.concatenate([ang, ang], axis=-1)
    return jnp.cos(ang), jnp.sin(ang)


def apply_rope(x, cos, sin):
    c = cos[None, :, None, :].astype(x.dtype)
    s = sin[None, :, None, :].astype(x.dtype)
    x1, x2 = jnp.split(x, 2, axis=-1)
    rot = jnp.concatenate([-x2, x1], axis=-1)
    return x * c + rot * s


def macaron_half_ffn(x, g_pre, g_post, w_in, w_out):
    h = rms_norm(x, g_pre)
    gu = h @ w_in
    gate, up = jnp.split(gu, 2, axis=-1)
    y = (jax.nn.silu(gate) * up) @ w_out
    return x + FFN_RESIDUAL_SCALE * rms_norm(y, g_post)


def diff_attention(h, w_qkv, lam_vecs, subln, w_o, lam_init, cos, sin):
    B, S, _ = h.shape
    H, Dh = DIFF_HEADS, HEAD_DIM
    q, k, v = jnp.split(h @ w_qkv, 3, axis=-1)
    q = apply_rope(q.reshape(B, S, 2 * H, Dh), cos, sin).transpose(0, 2, 1, 3)
    k = apply_rope(k.reshape(B, S, 2 * H, Dh), cos, sin).transpose(0, 2, 1, 3)
    v = v.reshape(B, S, H, 2 * Dh).transpose(0, 2, 1, 3)
    lv = lam_vecs.astype(jnp.float32)
    lam = jnp.exp(jnp.sum(lv[0] * lv[1])) - jnp.exp(jnp.sum(lv[2] * lv[3])) + lam_init
    nq = S // DIFF_Q_CHUNK
    q_chunks = q.reshape(B, 2 * H, nq, DIFF_Q_CHUNK, Dh).transpose(2, 0, 1, 3, 4)
    kpos = jnp.arange(S)
    scale = Dh ** -0.5

    def one_chunk(args):
        c, qc = args
        qpos = c * DIFF_Q_CHUNK + jnp.arange(DIFF_Q_CHUNK)
        s = jnp.einsum('bhqd,bhkd->bhqk', qc, k).astype(jnp.float32) * scale
        s = jnp.where(kpos[None, :] <= qpos[:, None], s, -jnp.inf)
        p = jax.nn.softmax(s, axis=-1).reshape(B, H, 2, DIFF_Q_CHUNK, S)
        a = p[:, :, 0] - lam * p[:, :, 1]
        return jnp.einsum('bhqk,bhkd->bhqd', a.astype(v.dtype), v)

    o = lax.map(one_chunk, (jnp.arange(nq), q_chunks))
    o = o.transpose(1, 0, 3, 2, 4).reshape(B, S, H, 2 * Dh)
    o = rms_norm(o, subln) * (1.0 - lam_init)
    return o.reshape(B, S, D_MODEL) @ w_o


def shared_kv(x, kv_norm, kv_w, cos, sin):
    B, S, _ = x.shape
    H, Dh = MOBA_HEADS, HEAD_DIM
    k, v = jnp.split(rms_norm(x, kv_norm) @ kv_w, 2, axis=-1)
    k = apply_rope(k.reshape(B, S, H, Dh), cos, sin).transpose(0, 2, 1, 3)
    v = v.reshape(B, S, H, Dh).transpose(0, 2, 1, 3)
    nb = -(-S // MOBA_BLOCK)
    pad = nb * MOBA_BLOCK - S
    k = jnp.pad(k, ((0, 0), (0, 0), (0, pad), (0, 0)))
    v = jnp.pad(v, ((0, 0), (0, 0), (0, pad), (0, 0)))
    kb = k.reshape(B, H, nb, MOBA_BLOCK, Dh)
    vb = v.reshape(B, H, nb, MOBA_BLOCK, Dh)
    kmean = jnp.mean(kb.astype(jnp.float32), axis=3).astype(kb.dtype)
    return kb, vb, kmean


def moba_attention(h, w_q, w_o, kb, vb, kmean, cos, sin):
    B, S, _ = h.shape
    H, Dh = MOBA_HEADS, HEAD_DIM
    q = apply_rope((h @ w_q).reshape(B, S, H, Dh), cos, sin).transpose(0, 2, 1, 3)
    nb = kb.shape[2]
    topk = min(MOBA_TOPK, nb)
    nq = S // MOBA_Q_CHUNK
    q_chunks = q.reshape(B, H, nq, MOBA_Q_CHUNK, Dh).transpose(2, 0, 1, 3, 4)
    bi = jnp.arange(B)[:, None, None, None]
    hi = jnp.arange(H)[None, :, None, None]
    blk_ids = jnp.arange(nb)
    in_blk = jnp.arange(MOBA_BLOCK)
    scale = Dh ** -0.5

    def one_chunk(args):
        c, qc = args
        q0 = c * MOBA_Q_CHUNK
        qpos = q0 + jnp.arange(MOBA_Q_CHUNK)
        qblk = q0 // MOBA_BLOCK
        gate = jnp.einsum('bhqd,bhnd->bhqn', qc, kmean).astype(jnp.float32)
        gate = jnp.where(blk_ids < qblk, gate, -jnp.inf)
        _, idx = lax.top_k(gate, topk)
        valid = idx < qblk
        ksel = kb[bi, hi, idx]
        vsel = vb[bi, hi, idx]
        s_sel = jnp.einsum('bhqd,bhqjpd->bhqjp', qc, ksel).astype(jnp.float32) * scale
        s_sel = jnp.where(valid[..., None], s_sel, -jnp.inf)
        s_sel = s_sel.reshape(B, H, MOBA_Q_CHUNK, topk * MOBA_BLOCK)
        kown = lax.dynamic_index_in_dim(kb, qblk, axis=2, keepdims=False)
        vown = lax.dynamic_index_in_dim(vb, qblk, axis=2, keepdims=False)
        s_own = jnp.einsum('bhqd,bhpd->bhqp', qc, kown).astype(jnp.float32) * scale
        kpos = qblk * MOBA_BLOCK + in_blk
        s_own = jnp.where(kpos[None, :] <= qpos[:, None], s_own, -jnp.inf)
        p = jax.nn.softmax(jnp.concatenate([s_sel, s_own], axis=-1), axis=-1).astype(vb.dtype)
        p_sel = p[..., :topk * MOBA_BLOCK].reshape(B, H, MOBA_Q_CHUNK, topk, MOBA_BLOCK)
        p_own = p[..., topk * MOBA_BLOCK:]
        return (jnp.einsum('bhqjp,bhqjpd->bhqd', p_sel, vsel)
                + jnp.einsum('bhqp,bhpd->bhqd', p_own, vown))

    o = lax.map(one_chunk, (jnp.arange(nq), q_chunks))
    o = o.transpose(1, 0, 3, 2, 4).reshape(B, S, D_MODEL)
    return o @ w_o


def setup_inputs(seed: int = 0) -> dict:
    key = jax.random.key(seed)
    ks = jax.random.split(key, 16)
    f32 = jnp.float32
    nrm = lambda k, shape, s: jax.random.normal(k, shape, f32) * s
    gain = lambda k, shape: 1.0 + 0.05 * jax.random.normal(k, shape, f32)
    return {
        "x": jax.random.normal(ks[0], (BATCH, SEQ, D_MODEL), f32),
        "ffn_norm": gain(ks[1], (DEPTH, 2, 2, D_MODEL)),
        "ffn_w_in": nrm(ks[2], (DEPTH, 2, D_MODEL, 2 * D_FF), D_MODEL ** -0.5),
        "ffn_w_out": nrm(ks[3], (DEPTH, 2, D_FF, D_MODEL), D_FF ** -0.5),
        "mix_norm": gain(ks[4], (DEPTH, 2, D_MODEL)),
        "diff_w_qkv": nrm(ks[5], (N_A_LAYERS, D_MODEL, 3 * D_MODEL), D_MODEL ** -0.5),
        "diff_lambda": nrm(ks[6], (N_A_LAYERS, 4, HEAD_DIM), 0.1),
        "diff_subln": gain(ks[7], (N_A_LAYERS, 2 * HEAD_DIM)),
        "diff_w_o": nrm(ks[8], (N_A_LAYERS, D_MODEL, D_MODEL), D_MODEL ** -0.5),
        "kv_norm": gain(ks[9], (D_MODEL,)),
        "kv_w": nrm(ks[10], (D_MODEL, 2 * D_MODEL), D_MODEL ** -0.5),
        "moba_w_q": nrm(ks[11], (N_B_LAYERS, D_MODEL, D_MODEL), D_MODEL ** -0.5),
        "moba_w_o": nrm(ks[12], (N_B_LAYERS, D_MODEL, D_MODEL), D_MODEL ** -0.5),
    }


def reference(x, ffn_norm, ffn_w_in, ffn_w_out, mix_norm, diff_w_qkv, diff_lambda,
              diff_subln, diff_w_o, kv_norm, kv_w, moba_w_q, moba_w_o):
    S = x.shape[1]
    cos, sin = rope_tables(S, HEAD_DIM)
    kb = vb = kmean = None
    for l in range(DEPTH):
        if l == N_A_LAYERS:
            kb, vb, kmean = shared_kv(x, kv_norm, kv_w, cos, sin)
        x = macaron_half_ffn(x, ffn_norm[l, 0, 0], ffn_norm[l, 0, 1], ffn_w_in[l, 0], ffn_w_out[l, 0])
        h = rms_norm(x, mix_norm[l, 0])
        if l < N_A_LAYERS:
            lam_init = 0.8 - 0.6 * math.exp(-0.3 * l)
            y = diff_attention(h, diff_w_qkv[l], diff_lambda[l], diff_subln[l], diff_w_o[l],
                               lam_init, cos, sin)
        else:
            j = l - N_A_LAYERS
            y = moba_attention(h, moba_w_q[j], moba_w_o[j], kb, vb, kmean, cos, sin)
        x = x + rms_norm(y, mix_norm[l, 1])
        x = macaron_half_ffn(x, ffn_norm[l, 1, 0], ffn_norm[l, 1, 1], ffn_w_in[l, 1], ffn_w_out[l, 1])
    return x
```

```cpp
#include <hip/hip_runtime.h>
#include <cstdio>
#include <cstdint>
#include <cmath>
namespace pg8 {
#define PG8_LAS __attribute__((address_space(3)))
typedef unsigned short bf16_t;
typedef short bf16x8 __attribute__((ext_vector_type(8)));
typedef _Float16 h8 __attribute__((ext_vector_type(8)));
typedef _Float16 h2 __attribute__((ext_vector_type(2)));
typedef float f32x4 __attribute__((ext_vector_type(4)));
typedef unsigned u32x4 __attribute__((ext_vector_type(4)));
constexpr int BM = 256, BK = 64, HALF = 128, HTB = HALF * BK * 2  , STAGE_BYTES = 8 * HTB, NXCD = 8, WGM = 8;

__host__ __device__ __forceinline__ int lds_byte(int r, int c) { const int st = (r >> 4) * 2 + (c >> 5), rr = r & 15, cc = c & 31, ob = rr * 64 + cc * 2; return st * 1024 + (ob ^ (((ob >> 9) & 1) << 5)); }
__host__ __device__ __forceinline__ void stage_rc(int b, int& R, int& C) { const int st = b / 1024, sb = b % 1024, swz = sb ^ (((sb >> 9) & 1) << 5); R = (st >> 1) * 16 + swz / 64; C = (st & 1) * 32 + (swz % 64) / 2; }
__host__ __device__ __forceinline__ int perm32(int rho) { const int n = rho >> 4, i = rho & 15; return 8 * (i >> 2) + 4 * n + (i & 3); }

struct Unit { int pm, pn; };
struct Gemm { const bf16_t* A; const bf16_t* Bt; int M, N, K; };

struct StaticOrder {
    int nM, nN, nwg, G, c;
    __host__ __device__ void init(int M, int N, int G_, int c_) { nM = M / BM; nN = N / BM; nwg = nM * nN; G = G_; c = c_; }
    __host__ __device__ bool next(int i, Unit& u) const {
        const long L = (long)i * G + c; if (L >= nwg) return false;
        int wgid = (int)L; { const int q = nwg / NXCD, r = nwg % NXCD, xcd = wgid % NXCD, off = wgid / NXCD; wgid = (xcd < r ? xcd * (q + 1) : r * (q + 1) + (xcd - r) * q) + off; }
        const int nig = WGM * nN, gid = wgid / nig, fm = gid * WGM, gsz = (nM - fm) < WGM ? (nM - fm) : WGM;
        u.pm = fm + ((wgid % nig) % gsz); u.pn = (wgid % nig) / gsz; return true;
    }
    __device__ __forceinline__ void a_ready(const Unit&) const {}
    __device__ __forceinline__ void done(const Unit&) const {}
};
typedef float f32x2 __attribute__((ext_vector_type(2)));
typedef unsigned u32x2 __attribute__((ext_vector_type(2)));
__device__ __forceinline__ unsigned cvt_pk_f16(float lo, float hi) { const f32x2 v = {lo, hi}; return __builtin_bit_cast(unsigned, __builtin_convertvector(v, h2)); }
struct EpiF32 {
    static constexpr bool PERM = false, AFTER_DRAIN = false;
    float* C; int ldc;
    __device__ __forceinline__ void operator()(const f32x4 (&acc)[2][2][4][2], const Unit& u, int wr, int wc, int fr, int fq) const {
        const int row0 = u.pm * BM + wr * 64 + fr, col0 = u.pn * BM + wc * 32 + 4 * fq;
#pragma unroll
        for (int ai = 0; ai < 2; ++ai)
#pragma unroll
            for (int m = 0; m < 4; ++m) { float* rowp = C + (size_t)(row0 + ai * HALF + m * 16) * ldc + col0;
#pragma unroll
                for (int bj = 0; bj < 2; ++bj)
#pragma unroll
                    for (int n = 0; n < 2; ++n) *(f32x4*)(rowp + bj * HALF + n * 16) = acc[ai][bj][m][n]; }
    }
};
struct EpiSwiglu {
    static constexpr bool PERM = true, AFTER_DRAIN = false;
    bf16_t* H; int ldh;
    __device__ __forceinline__ void operator()(const f32x4 (&acc)[2][2][4][2], const Unit& u, int wr, int wc, int fr, int fq) const {
        const int row0 = u.pm * BM + wr * 64 + fr, hc0 = u.pn * (BM / 2) + wc * 16 + 4 * fq;
#pragma unroll
        for (int ai = 0; ai < 2; ++ai)
#pragma unroll
            for (int m = 0; m < 4; ++m) { bf16_t* rowp = H + (size_t)(row0 + ai * HALF + m * 16) * ldh + hc0;
#pragma unroll
                for (int bj = 0; bj < 2; ++bj) { const f32x4 g = acc[ai][bj][m][0], up = acc[ai][bj][m][1]; float s[4];
#pragma unroll
                    for (int e = 0; e < 4; ++e) { const float ex = __builtin_amdgcn_exp2f(g[e] * -1.4426950408889634f); s[e] = g[e] * __builtin_amdgcn_rcpf(1.0f + ex) * up[e]; }
                    u32x2 w; w.x = cvt_pk_f16(s[0], s[1]); w.y = cvt_pk_f16(s[2], s[3]);
                    *(u32x2*)(rowp + bj * (HALF / 2)) = w; } }
    }
};
struct EpiRope3 {
    static constexpr bool PERM = true, AFTER_DRAIN = false;
    bf16_t* out0; size_t split_stride; unsigned ropemask; float scale0; const float* rope; int ldc;
    __device__ __forceinline__ void operator()(const f32x4 (&acc)[2][2][4][2], const Unit& u, int wr, int wc, int fr, int fq) const {
        const int t = (u.pn * BM) >> 10, colt = u.pn * BM - (t << 10); bf16_t* base = out0 + (size_t)t * split_stride;
        const float sc = (t == 0) ? scale0 : 1.0f; const bool dorope = ((ropemask >> t) & 1u) != 0u;
        const int row0 = u.pm * BM + wr * 64 + fr, col0 = colt + wc * 32 + 8 * fq;
#pragma unroll
        for (int ai = 0; ai < 2; ++ai)
#pragma unroll
            for (int m = 0; m < 4; ++m) { const int row = row0 + ai * HALF + m * 16; bf16_t* rowp = base + (size_t)row * ldc + col0;
#pragma unroll
                for (int bj = 0; bj < 2; ++bj) { f32x4 v0 = acc[ai][bj][m][0], v1 = acc[ai][bj][m][1];
                    if (dorope) { const int i0 = ((col0 + bj * HALF) & 63) >> 1; const float* rp = rope + ((size_t)row * 32 + i0) * 2;
                        const f32x4 c0 = *(const f32x4*)rp, c1 = *(const f32x4*)(rp + 4);
                        f32x4 r0, r1;
                        r0[0] = v0[0] * c0[0] - v0[1] * c0[1]; r0[1] = v0[1] * c0[0] + v0[0] * c0[1]; r0[2] = v0[2] * c0[2] - v0[3] * c0[3]; r0[3] = v0[3] * c0[2] + v0[2] * c0[3];
                        r1[0] = v1[0] * c1[0] - v1[1] * c1[1]; r1[1] = v1[1] * c1[0] + v1[0] * c1[1]; r1[2] = v1[2] * c1[2] - v1[3] * c1[3]; r1[3] = v1[3] * c1[2] + v1[2] * c1[3];
                        v0 = r0; v1 = r1; }
                    v0 = v0 * sc; v1 = v1 * sc; u32x4 w; w.x = cvt_pk_f16(v0[0], v0[1]); w.y = cvt_pk_f16(v0[2], v0[3]); w.z = cvt_pk_f16(v1[0], v1[1]); w.w = cvt_pk_f16(v1[2], v1[3]);
                    *(u32x4*)(rowp + bj * HALF) = w; } }
    }
};

template <class Epi, class Sched, bool ALIGN_EPI = false, bool SP2 = false>
__device__ __forceinline__ void gemm_phase(PG8_LAS unsigned char* lds, const Gemm g, const Sched& S, const Epi& E) {
    const int tid = threadIdx.x, wid = __builtin_amdgcn_readfirstlane(tid >> 6), lane = tid & 63, wr = wid >> 2, wc = wid & 3, fr = lane & 15, fq = lane >> 4;
    const int K = g.K, nt = K / BK;
    unsigned voffA[2], voffB[2];
#pragma unroll
    for (int i = 0; i < 2; ++i) { int R, C; stage_rc(tid * 16 + i * 8192, R, C); const int Rb = Epi::PERM ? ((R & ~31) + perm32(R & 31)) : R;
        voffA[i] = (unsigned)(R * K + C) * 2u; voffB[i] = (unsigned)(Rb * K + C) * 2u; }
    const size_t kstep = (size_t)(BK * 2);
    const size_t hstep = (size_t)HALF * K * 2;
    const size_t tstep = 2 * hstep;
    const unsigned ldsw = (unsigned)wid * 1024u;
    const int aoff = lds_byte(wr * 64 + fr, fq * 8), boff = lds_byte(wc * 32 + fr, fq * 8);
#define PG8_SA(b, h) (((b) * 2 + (h)) * HTB)
#define PG8_SB(b, h) ((4 + (b) * 2 + (h)) * HTB)
#define PG8_STAGE(bufoff, gbase, voff) do { _Pragma("unroll") for (int _i = 0; _i < 2; ++_i) \
        __builtin_amdgcn_global_load_lds((const unsigned*)((const char*)(gbase) + (voff)[_i]), (PG8_LAS unsigned*)(lds + (bufoff) + ldsw + _i * 8192), 16, 0, 0); } while (0)
#define PG8_LDA(dst, b, h) do { _Pragma("unroll") for (int m = 0; m < 4; ++m) _Pragma("unroll") for (int k = 0; k < 2; ++k) dst[m][k] = *(const PG8_LAS h8*)(lds + PG8_SA(b, h) + aoff + m * 2048 + k * 1024); } while (0)
#define PG8_LDB(dst, b, h) do { _Pragma("unroll") for (int n = 0; n < 2; ++n) _Pragma("unroll") for (int k = 0; k < 2; ++k) dst[n][k] = *(const PG8_LAS h8*)(lds + PG8_SB(b, h) + boff + n * 2048 + k * 1024); } while (0)
#define PG8_MMA(ai, bj, At, Bt) do { __builtin_amdgcn_s_setprio(1); _Pragma("unroll") for (int m = 0; m < 4; ++m) _Pragma("unroll") for (int n = 0; n < 2; ++n) _Pragma("unroll") for (int k = 0; k < 2; ++k) \
        acc[ai][bj][m][n] = __builtin_amdgcn_mfma_f32_16x16x32_f16(Bt[n][k], At[m][k], acc[ai][bj][m][n], 0, 0, 0); __builtin_amdgcn_s_setprio(0); } while (0)
#define PG8_WAIT_V(n) asm volatile("s_waitcnt vmcnt(" #n ")" ::: "memory")
#define PG8_WAIT_L(n) asm volatile("s_waitcnt lgkmcnt(" #n ")" ::: "memory")
#define PG8_BAR __builtin_amdgcn_s_barrier()
#define PG8_SCHED __builtin_amdgcn_sched_barrier(0)
    Unit cur, nxt; int ui = 0;
    if (!S.next(0, cur)) return;
    f32x4 acc[2][2][4][2];
#pragma unroll
    for (int a = 0; a < 2; ++a)
#pragma unroll
        for (int b = 0; b < 2; ++b)
#pragma unroll
            for (int m = 0; m < 4; ++m)
#pragma unroll
                for (int n = 0; n < 2; ++n) acc[a][b][m][n] = (f32x4){0.f, 0.f, 0.f, 0.f};
    h8 At[4][2], B0[2][2], B1[2][2];
    const char* cA = (const char*)g.A + (size_t)cur.pm * tstep; const char* cB = (const char*)g.Bt + (size_t)cur.pn * tstep;
    S.a_ready(cur);
    if constexpr (SP2) {
        PG8_STAGE(PG8_SB(0, 0), cB, voffB); PG8_STAGE(PG8_SB(0, 1), cB + hstep, voffB); PG8_STAGE(PG8_SA(0, 0), cA, voffA); PG8_STAGE(PG8_SA(0, 1), cA + hstep, voffA);
        if (wr == 1) PG8_BAR;
        PG8_WAIT_V(2); PG8_BAR;
        PG8_STAGE(PG8_SB(1, 0), cB + kstep, voffB); PG8_STAGE(PG8_SA(1, 0), cA + kstep, voffA); PG8_STAGE(PG8_SB(1, 1), cB + hstep + kstep, voffB);
        PG8_WAIT_V(6); PG8_BAR;
    } else {
        PG8_STAGE(PG8_SB(0, 0), cB, voffB); PG8_STAGE(PG8_SA(0, 0), cA, voffA); PG8_STAGE(PG8_SB(0, 1), cB + hstep, voffB); PG8_STAGE(PG8_SA(0, 1), cA + hstep, voffA);
        if (wr == 1) PG8_BAR;
        PG8_WAIT_V(4); PG8_BAR;
        PG8_STAGE(PG8_SB(1, 0), cB + kstep, voffB); PG8_STAGE(PG8_SA(1, 0), cA + kstep, voffA); PG8_STAGE(PG8_SB(1, 1), cB + hstep + kstep, voffB);
        PG8_WAIT_V(6); PG8_BAR;
    }
    for (;;) {
        const bool has_next = S.next(ui + 1, nxt);
        const char* nA = has_next ? (const char*)g.A + (size_t)nxt.pm * tstep : cA; const char* nB = has_next ? (const char*)g.Bt + (size_t)nxt.pn * tstep : cB;
        for (int t = 0; t < nt; t += 2) {
            const bool last = (t == nt - 2);
            const char* a1 = cA + (size_t)(t + 1) * kstep;
            const char* a2 = last ? nA : cA + (size_t)(t + 2) * kstep; const char* b2 = last ? nB : cB + (size_t)(t + 2) * kstep;
            const char* a3 = a2 + kstep; const char* b3 = b2 + kstep;
            if (last && has_next) S.a_ready(nxt);
            if constexpr (SP2) {
            PG8_LDB(B0, 0, 0); PG8_LDB(B1, 0, 1); PG8_SCHED; PG8_LDA(At, 0, 0); PG8_STAGE(PG8_SA(1, 1), a1 + hstep, voffA);
            PG8_WAIT_V(8); PG8_WAIT_L(0); PG8_BAR; PG8_MMA(0, 0, At, B0); PG8_MMA(0, 1, At, B1); PG8_BAR; PG8_SCHED;
            PG8_LDA(At, 0, 1); PG8_STAGE(PG8_SB(0, 0), b2, voffB); PG8_STAGE(PG8_SB(0, 1), b2 + hstep, voffB); PG8_STAGE(PG8_SA(0, 0), a2, voffA);
            PG8_WAIT_V(8); PG8_WAIT_L(0); PG8_BAR; PG8_MMA(1, 0, At, B0); PG8_MMA(1, 1, At, B1); PG8_BAR; PG8_SCHED;
            PG8_LDB(B0, 1, 0); PG8_LDB(B1, 1, 1); PG8_SCHED; PG8_LDA(At, 1, 0); PG8_STAGE(PG8_SA(0, 1), a2 + hstep, voffA);
            PG8_WAIT_V(8); PG8_WAIT_L(0); PG8_BAR; PG8_MMA(0, 0, At, B0); PG8_MMA(0, 1, At, B1); PG8_BAR; PG8_SCHED;
            PG8_LDA(At, 1, 1); PG8_STAGE(PG8_SB(1, 0), b3, voffB); PG8_STAGE(PG8_SB(1, 1), b3 + hstep, voffB); PG8_STAGE(PG8_SA(1, 0), a3, voffA);
            PG8_WAIT_V(8); PG8_WAIT_L(0); PG8_BAR; PG8_MMA(1, 0, At, B0); PG8_MMA(1, 1, At, B1); PG8_BAR; PG8_SCHED;
            } else {
            PG8_LDB(B0, 0, 0); PG8_SCHED; PG8_LDA(At, 0, 0); PG8_STAGE(PG8_SA(1, 1), a1 + hstep, voffA);
            PG8_WAIT_L(8); PG8_BAR; PG8_WAIT_L(0); PG8_MMA(0, 0, At, B0); PG8_BAR; PG8_SCHED;
            PG8_LDB(B1, 0, 1); PG8_STAGE(PG8_SB(0, 0), b2, voffB);
            PG8_BAR; PG8_WAIT_L(0); PG8_MMA(0, 1, At, B1); PG8_BAR;
            PG8_LDA(At, 0, 1); PG8_STAGE(PG8_SA(0, 0), a2, voffA);
            PG8_BAR; PG8_WAIT_L(0); PG8_MMA(1, 0, At, B0); PG8_BAR; PG8_SCHED;
            PG8_STAGE(PG8_SB(0, 1), b2 + hstep, voffB);
            PG8_WAIT_V(6); PG8_BAR; PG8_MMA(1, 1, At, B1); PG8_BAR;
            PG8_LDB(B0, 1, 0); PG8_SCHED; PG8_LDA(At, 1, 0); PG8_STAGE(PG8_SA(0, 1), a2 + hstep, voffA);
            PG8_WAIT_L(8); PG8_BAR; PG8_WAIT_L(0); PG8_MMA(0, 0, At, B0); PG8_BAR; PG8_SCHED;
            PG8_LDB(B1, 1, 1); PG8_STAGE(PG8_SB(1, 0), b3, voffB);
            PG8_BAR; PG8_WAIT_L(0); PG8_MMA(0, 1, At, B1); PG8_BAR;
            PG8_LDA(At, 1, 1); PG8_STAGE(PG8_SA(1, 0), a3, voffA);
            PG8_BAR; PG8_WAIT_L(0); PG8_MMA(1, 0, At, B0); PG8_BAR; PG8_SCHED;
            PG8_STAGE(PG8_SB(1, 1), b3 + hstep, voffB);
            PG8_WAIT_V(6); PG8_BAR; PG8_MMA(1, 1, At, B1); PG8_BAR;
            }
        }
        if constexpr (ALIGN_EPI) { if (wr == 0) PG8_BAR; }
        if constexpr (!Epi::AFTER_DRAIN) { E(acc, cur, wr, wc, fr, fq); S.done(cur); }
        if (!has_next) break;
#pragma unroll
        for (int a = 0; a < 2; ++a)
#pragma unroll
            for (int b = 0; b < 2; ++b)
#pragma unroll
                for (int m = 0; m < 4; ++m)
#pragma unroll
                    for (int n = 0; n < 2; ++n) acc[a][b][m][n] = (f32x4){0.f, 0.f, 0.f, 0.f};
        cur = nxt; cA = nA; cB = nB; ++ui;
        if constexpr (ALIGN_EPI) { if (wr == 1) PG8_BAR; }
    }
    PG8_WAIT_V(0);
    if constexpr (!ALIGN_EPI) { if (wr == 0) PG8_BAR; }
    PG8_BAR;
    if constexpr (Epi::AFTER_DRAIN) { E.fused(acc, cur, wr, wc, fr, fq, lds, wid, lane); S.done(cur); }
#undef PG8_SA
#undef PG8_SB
#undef PG8_STAGE
#undef PG8_LDA
#undef PG8_LDB
#undef PG8_MMA
#undef PG8_WAIT_V
#undef PG8_WAIT_L
#undef PG8_BAR
#undef PG8_SCHED
}
}
namespace attn_body {
using bf16=_Float16;
using h8v=__attribute__((ext_vector_type(8)))_Float16;
using bf16x8=__attribute__((ext_vector_type(8)))short;
using s16x4=__attribute__((ext_vector_type(4)))short;
using f32x16=__attribute__((ext_vector_type(16)))float;
using u32x4=__attribute__((ext_vector_type(4)))unsigned;
constexpr int BATCH=1,NHEAD=16,SEQ=16384,D=64,DM=NHEAD*D;
constexpr int NW=8,QBLK=32,QB=QBLK*NW,KVBLK=64,NQB=SEQ/QB;
constexpr int ATTN_PITCH=DM, ATTN_UNIT_ROWS=QB;
__device__ __forceinline__ int crow(int r,int hi){return (r&3)+8*(r>>2)+4*hi;}
#define SBAR() __builtin_amdgcn_sched_barrier(0)
__device__ __forceinline__ f32x16 MF16(bf16x8 x,bf16x8 y,f32x16 c,int,int,int){return __builtin_amdgcn_mfma_f32_32x32x16_f16(__builtin_bit_cast(h8v,x),__builtin_bit_cast(h8v,y),c,0,0,0);}
__device__ __forceinline__ void cmask(f32x16&p0,f32x16&p1,int jb,int qrel,int hi){
  const float NEG=-INFINITY; int kb=64*jb+4*hi;
  #pragma unroll
  for(int r=0;r<16;++r){int kv=kb+(r&3)+8*(r>>2); if(kv>qrel)p0[r]=NEG; if(kv+32>qrel)p1[r]=NEG;}
}

constexpr int NSLOT=3, SLOTB=8192;
constexpr int LDS_K=0, LDS_V=NSLOT*SLOTB, LDS_WS=2*NSLOT*SLOTB, LDS_OST=LDS_WS+NW*64*4, LDS_BYTES=LDS_OST+NW*4096;
constexpr float C2=0.125f*1.4426950408889634f;
__device__ __forceinline__ void glds16(const void*gsrc,unsigned lds_dst){unsigned keep;
  asm volatile("s_mov_b32 %0, m0\n\ts_mov_b32 m0, %2\n\ts_nop 0\n\tglobal_load_lds_dwordx4 %1, off\n\ts_mov_b32 m0, %0":"=&s"(keep):"v"(gsrc),"s"(lds_dst):"memory");}
__device__ __forceinline__ float max3f(float a,float b,float c){float r;asm("v_max3_f32 %0, %1, %2, %3":"=v"(r):"v"(a),"v"(b),"v"(c));return r;}
__device__ __forceinline__ float max2f(float a,float b){float r;asm("v_max_f32_e32 %0, %1, %2":"=v"(r):"v"(a),"v"(b));return r;}
__device__ __forceinline__ float fadd_s(float a,float b){float r;asm("v_add_f32_e32 %0, %1, %2":"=v"(r):"v"(a),"v"(b));return r;}
__device__ __forceinline__ float fsub_s(float a,float b){float r;asm("v_sub_f32_e32 %0, %1, %2":"=v"(r):"v"(a),"v"(b));return r;}
typedef float f32x2_t __attribute__((ext_vector_type(2))); typedef _Float16 bf16x2_t __attribute__((ext_vector_type(2)));
__device__ __forceinline__ unsigned cvtpk_s(float lo,float hi){f32x2_t v={lo,hi};bf16x2_t b=__builtin_convertvector(v,bf16x2_t);return __builtin_bit_cast(unsigned,b);}
#define WAIT_BAR(N) asm volatile("s_waitcnt vmcnt(" #N ") lgkmcnt(0)\n\ts_barrier":::"memory")

__device__ __forceinline__ void qkt(f32x16&p0,f32x16&p1,const char*Kslot,const bf16x8*qr,const f32x16&negm,int r32,int hi){
  const char*kb=Kslot+hi*1024+r32*16;
  #pragma unroll
  for(int d0=0;d0<4;++d0){
    const bf16x8 b0=*reinterpret_cast<const bf16x8*>(kb+d0*2048);
    const bf16x8 b1=*reinterpret_cast<const bf16x8*>(kb+d0*2048+512);
    if(d0==0){p0=MF16(b0,qr[0],negm,0,0,0);p1=MF16(b1,qr[0],negm,0,0,0);}
    else{p0=MF16(b0,qr[d0],p0,0,0,0);p1=MF16(b1,qr[d0],p1,0,0,0);}}
}
typedef __attribute__((address_space(3))) const char* lds_cptr;
typedef short v4i16_t __attribute__((ext_vector_type(4)));
__device__ __forceinline__ void kload8(bf16x8*kf,lds_cptr kp){
  kf[0]=*(const __attribute__((address_space(3))) bf16x8*)(kp);      kf[1]=*(const __attribute__((address_space(3))) bf16x8*)(kp+512);
  kf[2]=*(const __attribute__((address_space(3))) bf16x8*)(kp+2048); kf[3]=*(const __attribute__((address_space(3))) bf16x8*)(kp+2560);
  kf[4]=*(const __attribute__((address_space(3))) bf16x8*)(kp+4096); kf[5]=*(const __attribute__((address_space(3))) bf16x8*)(kp+4608);
  kf[6]=*(const __attribute__((address_space(3))) bf16x8*)(kp+6144); kf[7]=*(const __attribute__((address_space(3))) bf16x8*)(kp+6656);
}
__device__ __forceinline__ void kload2(bf16x8*kf,lds_cptr kp,int j){ kf[2*j]=*(const __attribute__((address_space(3))) bf16x8*)(kp+j*2048); kf[2*j+1]=*(const __attribute__((address_space(3))) bf16x8*)(kp+j*2048+512); }
__device__ __forceinline__ s16x4 vtr(lds_cptr p){ return __builtin_bit_cast(s16x4,__builtin_amdgcn_ds_read_tr16_b64_v4i16((__attribute__((address_space(3))) v4i16_t*)p)); }
__device__ __forceinline__ float rowmax(const f32x16&p0,const f32x16&p1){
  float a=max3f(p0[0],p0[1],p1[0]),b=max3f(p0[2],p0[3],p1[1]);a=max3f(a,p1[2],p1[3]);
  #pragma unroll
  for(int r=4;r<16;r+=4){a=max3f(a,p0[r],p0[r+1]);b=max3f(b,p0[r+2],p0[r+3]);a=max3f(a,p1[r],p1[r+1]);b=max3f(b,p1[r+2],p1[r+3]);}
  const float m=max2f(a,b);
  auto rr=__builtin_amdgcn_permlane32_swap(__float_as_uint(m),__float_as_uint(m),false,false);
  return max2f(__uint_as_float(rr[0]),__uint_as_float(rr[1]));
}
__device__ __forceinline__ void pv(f32x16*o,int vb,bf16x8 pa0,bf16x8 pa1,bf16x8 pa2,bf16x8 pa3){
  #pragma unroll
  for(int d0=0;d0<2;++d0){s16x4 lo[4],hi[4];
    #pragma unroll
    for(int ks=0;ks<4;++ks){
      asm volatile("ds_read_b64_tr_b16 %0,%1 offset:%c2":"=&v"(lo[ks]):"v"(vb),"i"(d0*4096+ks*1024):"memory");
      asm volatile("ds_read_b64_tr_b16 %0,%1 offset:%c2":"=&v"(hi[ks]):"v"(vb),"i"(d0*4096+ks*1024+512):"memory");}
    asm volatile("s_waitcnt lgkmcnt(0)":::"memory");SBAR();
    #define PK(k) (bf16x8){lo[k][0],lo[k][1],lo[k][2],lo[k][3],hi[k][0],hi[k][1],hi[k][2],hi[k][3]}
    o[d0]=MF16(pa0,PK(0),o[d0],0,0,0);
    o[d0]=MF16(pa1,PK(1),o[d0],0,0,0);
    o[d0]=MF16(pa2,PK(2),o[d0],0,0,0);
    o[d0]=MF16(pa3,PK(3),o[d0],0,0,0);
    #undef PK
  }
}

#ifndef ATTN_STORE16
#define ATTN_STORE16(p,v) (*(u32x4*)(p)=(v))
#endif
template<int THRL,int OP> __device__ __forceinline__ void attn_unit(int qb,const bf16*Qh,const bf16*__restrict__ Kh,const bf16*__restrict__ Vh,bf16*Oh,char*shm){
  const int tid=threadIdx.x,lane=tid&63,r32=lane&31,hi=lane>>5; const int wid=__builtin_amdgcn_readfirstlane(tid>>6);
  const int q0=qb*QB;
  const bf16*Qw=Qh+(long)(q0+wid*QBLK)*DM;
  const unsigned lds0=(unsigned)(uintptr_t)shm;
  float*wsf=(float*)(shm+LDS_WS)+wid*64;
  const bf16*ksrc=Kh+(long)lane*DM+wid*8;
  const bf16*vsrc=Vh+(long)(16*(wid&3)+(lane>>2))*DM+(wid>>2)*32+(lane&3)*8;
  const unsigned kdst=lds0+LDS_K+wid*1024, vdst=lds0+LDS_V+wid*1024;
  #define DMA_K(t,slot) glds16(ksrc+(long)(t)*KVBLK*DM,(unsigned)__builtin_amdgcn_readfirstlane(kdst+(slot)))
  #define DMA_V(t,slot) glds16(vsrc+(long)(t)*KVBLK*DM,(unsigned)__builtin_amdgcn_readfirstlane(vdst+(slot)))
  const int vb0=(int)(lds0+LDS_V)+((lane>>4)&1)*32+(lane&3)*8+(4*hi+((lane&15)>>2))*64;
  const char*Kbase=shm+LDS_K; bf16x8 kf[8];
  const lds_cptr shm3=(lds_cptr)shm; const lds_cptr kp0=shm3+LDS_K+hi*1024+r32*16; const lds_cptr vp0=shm3+LDS_V+((lane>>4)&1)*32+(lane&3)*8+(4*hi+((lane&15)>>2))*64;
  const int NT=(q0+QB)/KVBLK;
  DMA_K(0,0);DMA_V(0,0);DMA_K(1,SLOTB);
  bf16x8 qr[4];
  #pragma unroll
  for(int d0=0;d0<4;++d0)qr[d0]=*reinterpret_cast<const bf16x8*>(&Qw[(long)r32*DM+d0*16+hi*8]);
  float mhat=0.f,l_reg=0.f;f32x16 o[2];o[0]=f32x16{};o[1]=f32x16{};f32x16 negm=f32x16{};asm volatile("":"+v"(negm));
  const int qrel=wid*QBLK+r32;
  #define CMASK(P0,P1,t) do{int jb_=(t)-(NT-4); if(jb_>=0)cmask(P0,P1,jb_,qrel,hi);}while(0)
  bool resc=false;
  #define START(P0,P1) do{ const float rm=rowmax(P0,P1); resc=false; \
    { const float dl=rm; mhat=fadd_s(mhat,dl); \
      _Pragma("unroll") for(int r=0;r<16;++r){P0[r]=fsub_s(P0[r],dl);P1[r]=fsub_s(P1[r],dl);} \
      _Pragma("unroll") for(int r=0;r<16;++r)negm[r]=-mhat; asm volatile("":"+v"(negm)); } \
    _Pragma("unroll") for(int r=0;r<16;++r)P0[r]=__builtin_amdgcn_exp2f(P0[r]); }while(0)
  #define RESC() do{ if(resc){ asm volatile("s_waitcnt lgkmcnt(0)":::"memory"); \
      _Pragma("unroll") for(int d_=0;d_<2;++d_) _Pragma("unroll") for(int r=0;r<16;++r)o[d_][r]*=wsf[crow(r,hi)]; } }while(0)
  f32x16 pA0,pA1,pB0,pB1;
  int sl_prev=0,sl_cur=0,sl_next=SLOTB;
  #define ROT() do{sl_prev=sl_cur;sl_cur=sl_next;sl_next=(sl_next==(NSLOT-1)*SLOTB)?0:sl_next+SLOTB;}while(0)
  DMA_K(2,2*SLOTB);
  WAIT_BAR(3);
  qkt(pA0,pA1,Kbase,qr,negm,r32,hi);asm volatile("s_nop 15\n\ts_nop 7":"+v"(pA0),"+v"(pA1));CMASK(pA0,pA1,0);
  START(pA0,pA1);
  _Pragma("unroll") for(int r=0;r<16;++r)pA1[r]=__builtin_amdgcn_exp2f(pA1[r]);
  WAIT_BAR(0);
  DMA_K(3,0);DMA_V(1,SLOTB);
  ROT();
  kload8(kf,kp0+sl_cur);
  WAIT_BAR(2);
  s16x4 vlo[8],vhi[8]; u32x4 pw0,pw1,pw2,pw3;
  #define PKW(P,B) cvtpk_s(P[B],P[B+1])
  #define PAF(k) __builtin_bit_cast(bf16x8,pw##k)
  #define VFR(i) (bf16x8){vlo[i][0],vlo[i][1],vlo[i][2],vlo[i][3],vhi[i][0],vhi[i][1],vhi[i][2],vhi[i][3]}
  #define PIN(x) asm volatile("":"+v"(x))
  #define MX3(a,b,c) __builtin_fmaxf(__builtin_fmaxf((a),(b)),(c))
  #define GAPA(MF,A0,A1,A2,A3,W0,W1,PW) do{ MF; sacc+=A0; sacc+=A1; sacc+=A2; sacc+=A3; PIN(sacc); W0; W1; PIN(PW); SBAR(); }while(0)
  #define EX(v) __builtin_amdgcn_exp2f(v)
  #define GAPB(MF,X,B) do{ MF; X[B]=EX(X[B]); X[B+1]=EX(X[B+1]); X[B+2]=EX(X[B+2]); X[B+3]=EX(X[B+3]); PIN(X); SBAR(); }while(0)
  #define VRD(i) do{ vlo[i]=vtr(vp_+(((i)>>2)*4096+((i)&3)*1024)); vhi[i]=vtr(vp_+(((i)>>2)*4096+((i)&3)*1024+512)); }while(0)
  #define KRD(G,j) do{ if(G){ kload2(kf,kp0+sl_next,j); SBAR(); } }while(0)
  #define STEP(C0,C1,P0,P1,t,GK,GV,GL) do{ SBAR(); \
    const lds_cptr vp_=vp0+sl_prev; \
    VRD(0); SBAR(); float sacc=(P0[0]+P0[1]); \
    GAPA(C0=MF16(kf[0],qr[0],negm,0,0,0), P0[2],P0[3],P0[4],P0[5],     pw0[0]=PKW(P0,0), pw0[1]=PKW(P0,2), pw0); \
    VRD(4); SBAR(); GAPA(C1=MF16(kf[1],qr[0],negm,0,0,0), P0[6],P0[7],P0[8],P0[9],     pw0[2]=PKW(P0,4), pw0[3]=PKW(P0,6), pw0); \
    VRD(1); SBAR(); GAPA(C0=MF16(kf[2],qr[1],C0,0,0,0),   P0[10],P0[11],P0[12],P0[13], pw1[0]=PKW(P0,8), pw1[1]=PKW(P0,10), pw1); \
    VRD(5); SBAR(); GAPA(C1=MF16(kf[3],qr[1],C1,0,0,0),   P0[14],P0[15],P1[0],P1[1],   pw1[2]=PKW(P0,12),pw1[3]=PKW(P0,14), pw1); \
    VRD(2); SBAR(); GAPA(C0=MF16(kf[4],qr[2],C0,0,0,0),   P1[2],P1[3],P1[4],P1[5],     pw2[0]=PKW(P1,0), pw2[1]=PKW(P1,2), pw2); \
    VRD(6); SBAR(); GAPA(C1=MF16(kf[5],qr[2],C1,0,0,0),   P1[6],P1[7],P1[8],P1[9],     pw2[2]=PKW(P1,4), pw2[3]=PKW(P1,6), pw2); \
    VRD(3); SBAR(); GAPA(C0=MF16(kf[6],qr[3],C0,0,0,0),   P1[10],P1[11],P1[12],P1[13], pw3[0]=PKW(P1,8), pw3[1]=PKW(P1,10), pw3); \
    VRD(7); SBAR(); GAPA(C1=MF16(kf[7],qr[3],C1,0,0,0),   P1[14],P1[15],0.f,0.f,       pw3[2]=PKW(P1,12),pw3[3]=PKW(P1,14), pw3); \
    l_reg+=sacc; \
    if(GK){DMA_K((t)+3,sl_cur);} if(GV){DMA_V((t)+1,sl_next);} \
    CMASK(C0,C1,t); \
    { float a=MX3(C0[0],C0[1],C1[0]),b=MX3(C0[2],C0[3],C1[1]); a=MX3(a,C1[2],C1[3]); \
      _Pragma("unroll") for(int r=4;r<16;r+=4){a=MX3(a,C0[r],C0[r+1]);b=MX3(b,C0[r+2],C0[r+3]);a=MX3(a,C1[r],C1[r+1]);b=MX3(b,C1[r+2],C1[r+3]);} \
      float rm=__builtin_fmaxf(a,b); { auto rr=__builtin_amdgcn_permlane32_swap(__float_as_uint(rm),__float_as_uint(rm),false,false); rm=__builtin_fmaxf(__uint_as_float(rr[0]),__uint_as_float(rr[1])); } \
      resc=false; \
      if(__builtin_expect(__any(rm>(float)THRL),0)){ const float dl=__builtin_fmaxf(rm,0.f); mhat+=dl; \
        _Pragma("unroll") for(int r=0;r<16;++r){C0[r]-=dl;C1[r]-=dl;} \
        _Pragma("unroll") for(int r=0;r<16;++r)negm[r]=-mhat; asm volatile("":"+v"(negm)); \
        const float f=__builtin_amdgcn_exp2f(-dl); l_reg*=f; if(hi==0)wsf[r32]=f; resc=true; } } \
    SBAR(); \
    GAPB(o[0]=MF16(PAF(0),VFR(0),o[0],0,0,0), C0,0); \
    GAPB(o[1]=MF16(PAF(0),VFR(4),o[1],0,0,0), C0,4); \
    KRD(GL,0); GAPB(o[0]=MF16(PAF(1),VFR(1),o[0],0,0,0), C0,8); \
    KRD(GL,1); GAPB(o[1]=MF16(PAF(1),VFR(5),o[1],0,0,0), C0,12); \
    KRD(GL,2); GAPB(o[0]=MF16(PAF(2),VFR(2),o[0],0,0,0), C1,0); \
    KRD(GL,3); GAPB(o[1]=MF16(PAF(2),VFR(6),o[1],0,0,0), C1,4); \
    GAPB(o[0]=MF16(PAF(3),VFR(3),o[0],0,0,0), C1,8); \
    GAPB(o[1]=MF16(PAF(3),VFR(7),o[1],0,0,0), C1,12); \
    }while(0)
  int t=1;
  #undef CMASK
  #define CMASK(P0,P1,t) do{}while(0)
  for(;t+5<NT;t+=2){
    STEP(pB0,pB1,pA0,pA1,t,true,true,true);     WAIT_BAR(2); RESC(); ROT();
    STEP(pA0,pA1,pB0,pB1,t+1,true,true,true);   WAIT_BAR(2); RESC(); ROT();
  }
  #undef CMASK
  #define CMASK(P0,P1,t) do{int jb_=(t)-(NT-4); if(jb_>=0)cmask(P0,P1,jb_,qrel,hi);}while(0)
  #define ENDW(tt) do{ if((tt)+3<NT){WAIT_BAR(2);} else if((tt)+2<NT){WAIT_BAR(1);} else {WAIT_BAR(0);} }while(0)
  for(;t+1<NT;t+=2){
    STEP(pB0,pB1,pA0,pA1,t,(t+3<NT),(t+1<NT),(t+1<NT));       ENDW(t);   RESC(); ROT();
    STEP(pA0,pA1,pB0,pB1,t+1,(t+4<NT),(t+2<NT),(t+2<NT));     ENDW(t+1); RESC(); ROT();
  }
  STEP(pB0,pB1,pA0,pA1,NT-1,false,false,false); RESC();
  { float sacc=pB0[0]+pB0[1]; _Pragma("unroll") for(int r=2;r<16;++r)sacc+=pB0[r]; _Pragma("unroll") for(int r=0;r<16;++r)sacc+=pB1[r]; l_reg+=sacc;
    pw0=(u32x4){PKW(pB0,0),PKW(pB0,2),PKW(pB0,4),PKW(pB0,6)};pw1=(u32x4){PKW(pB0,8),PKW(pB0,10),PKW(pB0,12),PKW(pB0,14)};pw2=(u32x4){PKW(pB1,0),PKW(pB1,2),PKW(pB1,4),PKW(pB1,6)};pw3=(u32x4){PKW(pB1,8),PKW(pB1,10),PKW(pB1,12),PKW(pB1,14)};
    SBAR(); pv(o,vb0+sl_cur,PAF(0),PAF(1),PAF(2),PAF(3)); }
  #undef PKW
  #undef PAF
  #undef VFR
  #undef PIN
  #undef MX3
  #undef GAPA
  #undef GAPB
  #undef EX
  #undef VRD
  #undef KRD
  #undef STEP
  #undef ENDW
  {auto rr=__builtin_amdgcn_permlane32_swap(__float_as_uint(l_reg),__float_as_uint(l_reg),false,false);l_reg=__uint_as_float(rr[0])+__uint_as_float(rr[1]);}
  if(hi==0)wsf[32+r32]=l_reg;asm volatile("s_waitcnt lgkmcnt(0)":::"memory");
  float rli[16];
  #pragma unroll
  for(int r=0;r<16;++r)rli[r]=__builtin_amdgcn_rcpf(wsf[32+crow(r,hi)]);
  bf16*Ow=Oh+(long)(q0+wid*QBLK)*OP;
  { bf16*stg=(bf16*)(shm+LDS_OST)+wid*2048;
    #pragma unroll
    for(int r=0;r<16;++r){const int orow=crow(r,hi);
      #pragma unroll
      for(int d0=0;d0<2;++d0)stg[orow*64+d0*32+r32]=(bf16)(o[d0][r]*rli[r]);}
    asm volatile("s_waitcnt lgkmcnt(0)":::"memory");
    #pragma unroll
    for(int i=0;i<4;++i){const int row=i*8+(lane>>3),ch=lane&7; const u32x4 v=*(const u32x4*)(stg+row*64+ch*8); ATTN_STORE16(Ow+(long)row*OP+ch*8,v);} }
  asm volatile("s_waitcnt lgkmcnt(0)\n\ts_barrier":::"memory");
  #undef DMA_K
  #undef DMA_V
  #undef CMASK
  #undef START
  #undef RESC
  #undef ROT
}
constexpr int ATTN_LDS_BYTES=LDS_BYTES;
#undef SBAR
#undef WAIT_BAR
}
constexpr int NWAVES = 8;
#ifndef MK_N_LAUNCHES
#define MK_N_LAUNCHES 1
#endif

constexpr int M = 16384, D = 1024, FF = 2816, NUP = 2 * FF, HD = 64;
constexpr float NORM_EPS = 1e-6f;
constexpr float C2 = 0.125f * 1.4426950408889634f;
constexpr float LAM_INIT = 0.2f;
typedef _Float16 f16;

constexpr size_t MiB = 1u << 20;
constexpr size_t WS_CTL = 0, CTL_ZERO_BYTES = 1 * MiB;
constexpr size_t WS_ROPE = 1 * MiB;
constexpr size_t WS_KMEAN = 5 * MiB;
constexpr size_t WS_W = 6 * MiB;
constexpr size_t W_IN_SZ = (size_t)NUP * D * 2, W_OUT_SZ = (size_t)D * FF * 2, W_SQ = (size_t)D * D * 2;
constexpr size_t WS_WIN = WS_W, WS_WOUT = WS_WIN + 4 * W_IN_SZ, WS_WQKV = WS_WOUT + 4 * W_OUT_SZ, WS_WOD = WS_WQKV + 3 * W_SQ, WS_WKV = WS_WOD + W_SQ, WS_WQM = WS_WKV + 2 * W_SQ, WS_WOM = WS_WQM + W_SQ;
static_assert(WS_WOM + W_SQ == 88 * MiB, "weights end at 88 MiB");
constexpr size_t ACT = (size_t)M * D * 2;
constexpr size_t WS_A1 = 88 * MiB;
constexpr size_t WS_XN = 216 * MiB;
constexpr size_t WS_Y = 152 * MiB;
constexpr size_t WS_A4 = 248 * MiB;
constexpr size_t WS_END = 336 * MiB;
static_assert(WS_A4 + (size_t)M * FF * 2 <= WS_END, "d_ws map");
constexpr int CW_TMO = 0, CW_CODE = 1, CW_BAR = 4096;

constexpr int RING_OFF = 0, RING_BYTES = 131072;
constexpr int LDSCTL_OFF = RING_BYTES, MISC_OFF = LDSCTL_OFF + 320;
constexpr int LDS_BYTES = 147456;
static_assert(MISC_OFF + 128 <= LDS_BYTES, "LDS map");

#define GAS __attribute__((address_space(1)))
#define LAS __attribute__((address_space(3)))
typedef unsigned v4u __attribute__((ext_vector_type(4)));
typedef unsigned v2u __attribute__((ext_vector_type(2)));
typedef float f32x4 __attribute__((ext_vector_type(4)));
typedef float f32x2 __attribute__((ext_vector_type(2)));
typedef _Float16 h8 __attribute__((ext_vector_type(8)));
typedef _Float16 h2 __attribute__((ext_vector_type(2)));
typedef GAS unsigned gu32;
#define RLX_AGENT __ATOMIC_RELAXED, __HIP_MEMORY_SCOPE_AGENT
#define LDS_WAIT() asm volatile("s_waitcnt lgkmcnt(0)" ::: "memory")
#define VM_WAIT() asm volatile("s_waitcnt vmcnt(0)" ::: "memory")
__device__ __forceinline__ unsigned pk2h(float lo, float hi) { const f32x2 v = {lo, hi}; return __builtin_bit_cast(unsigned, __builtin_convertvector(v, h2)); }

#define XB_TMO      128
#define XB_XCNT(j)  (256  + 64 * (j))
#define XB_XSUB(j)  (1280 + 64 * (j))
#define XB_XGEN(j)  (2304 + 64 * (j))
#define XB_TOP      3328
#define XB_TOPGEN   3392
#define XCD_BAR_WORDS 3456
#define XB_SPIN_CAP (1u << 18)

__device__ __forceinline__ unsigned xb_ld(unsigned* p)              { return __hip_atomic_load(p, __ATOMIC_RELAXED, __HIP_MEMORY_SCOPE_AGENT); }
__device__ __forceinline__ unsigned xb_add(unsigned* p, unsigned v) { return __hip_atomic_fetch_add(p, v, __ATOMIC_RELAXED, __HIP_MEMORY_SCOPE_AGENT); }
__device__ __forceinline__ unsigned xb_xcc_id() { return (unsigned)__builtin_amdgcn_s_getreg((3 << 11) | 20) & 0xFu; }
#define XB_SPIN(cond, bar) do { unsigned _sp = 0; while (cond) { __builtin_amdgcn_s_sleep(1); \
    if ((++_sp & 255u) == 0u) { if (xb_ld(&(bar)[XB_TMO])) break; if (_sp > XB_SPIN_CAP) { atomicAdd(&(bar)[XB_TMO], 1u); break; } } } } while (0)

struct XcdBarrier {
    unsigned* bar; unsigned x;
    volatile LAS unsigned* st;
};

__device__ __forceinline__ XcdBarrier xcd_barrier_post(unsigned* bar, volatile LAS unsigned* st) {
    XcdBarrier b; b.bar = bar; b.x = xb_xcc_id(); b.st = st;
    if (threadIdx.x == 0) (void)xb_add(&bar[XB_XCNT(b.x)], 1u);
    return b;
}
__device__ __forceinline__ void xcd_barrier_complete(unsigned* bar, unsigned x, unsigned& nloc, unsigned& nx) {
    const unsigned G = gridDim.x * gridDim.y * gridDim.z;
    unsigned sum, cnt, mine, sp = 0u;
    for (;;) {
        sum = 0u; cnt = 0u; mine = 0u;
#pragma unroll
        for (unsigned j = 0; j < 16; ++j) { const unsigned c = xb_ld(&bar[XB_XCNT(j)]); sum += c; cnt += (c > 0u) ? 1u : 0u; mine = (j == x) ? c : mine; }
        if (sum == G) break;
        __builtin_amdgcn_s_sleep(1);
        if ((++sp & 255u) == 0u) { if (xb_ld(&bar[XB_TMO])) break; if (sp > XB_SPIN_CAP) { atomicAdd(&bar[XB_TMO], 1u); break; } }
    }
    nloc = mine > 0u ? mine : 1u; nx = cnt > 0u ? cnt : 1u;
}

__device__ __forceinline__ void xcd_barrier(const XcdBarrier& b) {
    asm volatile("s_waitcnt vmcnt(0)" ::: "memory");
    __syncthreads();
    if (threadIdx.x == 0) {
        unsigned* bar = b.bar;
        __builtin_amdgcn_s_waitcnt(0);
        unsigned nloc = b.st[0], nx = b.st[1];
        if (nloc == 0u) { xcd_barrier_complete(bar, b.x, nloc, nx); b.st[0] = nloc; b.st[1] = nx; }
        const unsigned old = xb_add(&bar[XB_XSUB(b.x)], 1u);
        const unsigned gen = old / nloc;
        if (old + 1u == (gen + 1u) * nloc) {
            __builtin_amdgcn_fence(__ATOMIC_RELEASE, "agent");
            asm volatile("s_waitcnt vmcnt(0)" ::: "memory");
            const unsigned og = xb_add(&bar[XB_TOP], 1u);
            const unsigned tg = og / nx;
            if (og + 1u == (tg + 1u) * nx) xb_add(&bar[XB_TOPGEN], 1u);
            else XB_SPIN(xb_ld(&bar[XB_TOPGEN]) == tg, bar);
            __builtin_amdgcn_fence(__ATOMIC_ACQUIRE, "agent");
            xb_add(&bar[XB_XGEN(b.x)], 1u);
            asm volatile("s_waitcnt vmcnt(0)" ::: "memory");
        } else {
            XB_SPIN(xb_ld(&bar[XB_XGEN(b.x)]) == gen, bar);
            __builtin_amdgcn_fence(__ATOMIC_ACQUIRE, "agent");
            asm volatile("s_waitcnt vmcnt(0)" ::: "memory");
        }
    }
    __syncthreads();
}

struct Frame {
    LAS unsigned char* lds;
    volatile LAS unsigned* MISC;
    gu32* ctl;
    int tid, lane, wave;
    int vcu, G;
};
__device__ __forceinline__ float wave_sum(float v) {
#pragma unroll
    for (int o = 1; o < 64; o <<= 1) v += __shfl_xor(v, o);
    return v;
}
__device__ __forceinline__ float wave_max(float v) {
#pragma unroll
    for (int o = 1; o < 64; o <<= 1) v = fmaxf(v, __shfl_xor(v, o));
    return v;
}
__device__ __forceinline__ int wmap(int mode, int n) {
    if (mode == 0) return n;
    if (mode == 1) { const int isup = n >= FF ? 1 : 0, g = isup ? n - FF : n; return 8 * (g >> 2) + 4 * isup + (g & 3); }
    if (n < mode) { const int h = n >> 6, d = n & 63; return (h << 6) + 2 * (d & 31) + (d >> 5); }
    return n;
}
__device__ __forceinline__ void p0_transpose_item(const float* W, int K, int N, f16* WT, int mode, const float* gain, LAS float* scr, int item, int lane) {
    const int nblk = N / 32, kb = item / nblk, nb = item % nblk, k0 = 64 * kb, n0 = 32 * nb;
#pragma unroll 8
    for (int i = 0; i < 32; ++i) { const int kk = 2 * i + (lane >> 5); const float gk = gain ? gain[k0 + kk] : 1.0f; scr[kk * 33 + (lane & 31)] = W[(size_t)(k0 + kk) * N + n0 + (lane & 31)] * gk; }
    LDS_WAIT(); asm volatile("" ::: "memory");
    const int c = lane & 7;
#pragma unroll
    for (int j = 0; j < 4; ++j) { const int n = (lane >> 3) + 8 * j; const LAS float* s = scr + (8 * c) * 33 + n;
        v4u o; o.x = pk2h(s[0 * 33], s[1 * 33]); o.y = pk2h(s[2 * 33], s[3 * 33]); o.z = pk2h(s[4 * 33], s[5 * 33]); o.w = pk2h(s[6 * 33], s[7 * 33]);
        *(GAS v4u*)(WT + (size_t)wmap(mode, n0 + n) * K + k0 + 8 * c) = o; }
    LDS_WAIT(); asm volatile("" ::: "memory");
}
__device__ const float ROPE_INV_FREQ[32] = {
    1.000000000e+00f, 7.498942018e-01f, 5.623413324e-01f, 4.216965139e-01f, 3.162277639e-01f, 2.371373922e-01f, 1.778279394e-01f, 1.333521456e-01f,
    1.000000015e-01f, 7.498941571e-02f, 5.623412877e-02f, 4.216964915e-02f, 3.162277862e-02f, 2.371373586e-02f, 1.778279431e-02f, 1.333521493e-02f,
    9.999999776e-03f, 7.498942316e-03f, 5.623413250e-03f, 4.216964822e-03f, 3.162277862e-03f, 2.371373819e-03f, 1.778279431e-03f, 1.333521446e-03f,
    1.000000047e-03f, 7.498941850e-04f, 5.623413017e-04f, 4.216965463e-04f, 3.162277862e-04f, 2.371373848e-04f, 1.778279402e-04f, 1.333521504e-04f };
__device__ __forceinline__ void rope_entry(int pos, int i, float& c, float& s) {
    const float angf = (float)pos * ROPE_INV_FREQ[i];
    const double a = (double)angf;
    const double kd = __builtin_rint(a * 0.63661977236758134308);
    double t = __builtin_fma(-kd, 1.57079632679489655800e+00, a); t = __builtin_fma(-kd, 6.12323399573676603587e-17, t);
    const double t2 = t * t;
    double sp = -7.6471637318198164759e-13;
    sp = sp * t2 + 1.6059043836821614599e-10;
    sp = sp * t2 - 2.5052108385441718775e-08;
    sp = sp * t2 + 2.7557319223985890653e-06;
    sp = sp * t2 - 1.9841269841269841270e-04;
    sp = sp * t2 + 8.3333333333333333333e-03;
    sp = sp * t2 - 1.6666666666666666667e-01;
    const double sn = t + t * t2 * sp;
    double cp = 4.7794773323873852974e-14;
    cp = cp * t2 - 1.1470745597729724714e-11;
    cp = cp * t2 + 2.0876756987868098979e-09;
    cp = cp * t2 - 2.7557319223985890653e-07;
    cp = cp * t2 + 2.4801587301587301587e-05;
    cp = cp * t2 - 1.3888888888888888889e-03;
    cp = cp * t2 + 4.1666666666666666667e-02;
    cp = cp * t2 - 0.5;
    const double cs = 1.0 + t2 * cp;
    const int q = (int)((long long)kd & 3);
    const double sv = (q == 0) ? sn : (q == 1) ? cs : (q == 2) ? -sn : -cs;
    const double cv = (q == 0) ? cs : (q == 1) ? -sn : (q == 2) ? -cs : sn;
    c = (float)cv; s = (float)sv;
}
__device__ __forceinline__ void rms_rows(Frame& F, const float* x, f16* XN) {
    const int gw = F.vcu * NWAVES + F.wave, NGW = F.G * NWAVES;
    for (int m = gw; m < M; m += NGW) {
        const GAS f32x4* xr = (const GAS f32x4*)(x + (size_t)m * D) + F.lane;
        f32x4 v[4]; float s = 0.f;
#pragma unroll
        for (int j = 0; j < 4; ++j) { v[j] = xr[64 * j]; s += (v[j].x * v[j].x + v[j].y * v[j].y) + (v[j].z * v[j].z + v[j].w * v[j].w); }
        const float r = 1.0f / sqrtf(wave_sum(s) * (1.0f / D) + NORM_EPS);
        GAS v2u* o8 = (GAS v2u*)(XN + (size_t)m * D) + F.lane;
#pragma unroll
        for (int j = 0; j < 4; ++j) { v2u w; w.x = pk2h(v[j].x * r, v[j].y * r); w.y = pk2h(v[j].z * r, v[j].w * r); o8[64 * j] = w; }
    }
}
__device__ __forceinline__ void norm_phase(Frame& F, const float* xin, const float* Y, const float* g, float alpha, float* xout, f16* XN) {
    const int gw = F.vcu * NWAVES + F.wave, NGW = F.G * NWAVES;
    f32x4 gv[4];
#pragma unroll
    for (int j = 0; j < 4; ++j) gv[j] = ((const GAS f32x4*)g)[F.lane + 64 * j] * alpha;
    for (int m = gw; m < M; m += NGW) {
        const GAS f32x4* yr = (const GAS f32x4*)(Y + (size_t)m * D) + F.lane;
        const GAS f32x4* xr = (const GAS f32x4*)(xin + (size_t)m * D) + F.lane;
        f32x4 y[4], x[4]; float s = 0.f;
#pragma unroll
        for (int j = 0; j < 4; ++j) { y[j] = yr[64 * j]; x[j] = xr[64 * j]; s += (y[j].x * y[j].x + y[j].y * y[j].y) + (y[j].z * y[j].z + y[j].w * y[j].w); }
        const float ry = 1.0f / sqrtf(wave_sum(s) * (1.0f / D) + NORM_EPS);
        float s2 = 0.f;
#pragma unroll
        for (int j = 0; j < 4; ++j) { x[j] = x[j] + (y[j] * ry) * gv[j]; s2 += (x[j].x * x[j].x + x[j].y * x[j].y) + (x[j].z * x[j].z + x[j].w * x[j].w); }
        GAS f32x4* xo = (GAS f32x4*)(xout + (size_t)m * D) + F.lane;
#pragma unroll
        for (int j = 0; j < 4; ++j) xo[64 * j] = x[j];
        if (XN) {
            const float r = 1.0f / sqrtf(wave_sum(s2) * (1.0f / D) + NORM_EPS);
            GAS v2u* o8 = (GAS v2u*)(XN + (size_t)m * D) + F.lane;
#pragma unroll
            for (int j = 0; j < 4; ++j) { v2u w; w.x = pk2h(x[j].x * r, x[j].y * r); w.y = pk2h(x[j].z * r, x[j].w * r); o8[64 * j] = w; }
        }
    }
}
__device__ __forceinline__ void p0_prologue(Frame& F, const float* const* in, unsigned char* ws) {
    LAS float* scr = (LAS float*)(F.lds + RING_OFF + F.wave * 16384);
    const int gw = F.vcu * NWAVES + F.wave, NGW = F.G * NWAVES;
    const float* ffn_norm = in[1]; const float* w_in = in[2]; const float* w_out = in[3]; const float* mix_norm = in[4];
    constexpr int I_IN = (D / 64) * (NUP / 32), I_OUT = (FF / 64) * (D / 32), I_SQ = (D / 64) * (D / 32);
    constexpr int NITEMS = 4 * I_IN + 4 * I_OUT + 3 * I_SQ + I_SQ + 2 * I_SQ + I_SQ + I_SQ;
    for (int it = gw; it < NITEMS; it += NGW) {
        int r = it;
        if (r < 4 * I_IN) { const int f = r / I_IN; r -= f * I_IN; p0_transpose_item(w_in + (size_t)f * D * NUP, D, NUP, (f16*)(ws + WS_WIN + f * W_IN_SZ), 1, ffn_norm + (f * 2 + 0) * D, scr, r, F.lane); continue; } r -= 4 * I_IN;
        if (r < 4 * I_OUT) { const int f = r / I_OUT; r -= f * I_OUT; p0_transpose_item(w_out + (size_t)f * FF * D, FF, D, (f16*)(ws + WS_WOUT + f * W_OUT_SZ), 0, nullptr, scr, r, F.lane); continue; } r -= 4 * I_OUT;
        if (r < 3 * I_SQ) { p0_transpose_item(in[5], D, 3 * D, (f16*)(ws + WS_WQKV), 2 * D, mix_norm + 0 * D, scr, r, F.lane); continue; } r -= 3 * I_SQ;
        if (r < I_SQ) { p0_transpose_item(in[8], D, D, (f16*)(ws + WS_WOD), 0, nullptr, scr, r, F.lane); continue; } r -= I_SQ;
        if (r < 2 * I_SQ) { p0_transpose_item(in[10], D, 2 * D, (f16*)(ws + WS_WKV), D, in[9], scr, r, F.lane); continue; } r -= 2 * I_SQ;
        if (r < I_SQ) { p0_transpose_item(in[11], D, D, (f16*)(ws + WS_WQM), D, mix_norm + 2 * D, scr, r, F.lane); continue; } r -= I_SQ;
        p0_transpose_item(in[12], D, D, (f16*)(ws + WS_WOM), 0, nullptr, scr, r, F.lane);
    }
    {
        GAS f32x2* tab = (GAS f32x2*)(ws + WS_ROPE);
        for (int idx = (F.vcu * NWAVES + F.wave) * 64 + F.lane; idx < M * 32; idx += F.G * NWAVES * 64) { float c, s; rope_entry(idx >> 5, idx & 31, c, s); tab[idx] = (f32x2){c, s}; }
    }
    rms_rows(F, in[0], (f16*)(ws + WS_XN));
}
__device__ __forceinline__ void diff_combine(Frame& F, const f16* O2, const float* lamv, const float* subln, f16* A) {
    const int gw = F.vcu * NWAVES + F.wave, NGW = F.G * NWAVES;
    const float s1 = wave_sum(lamv[F.lane] * lamv[64 + F.lane]), s2 = wave_sum(lamv[128 + F.lane] * lamv[192 + F.lane]);
    const float lam = expf(s1) - expf(s2) + LAM_INIT;
    const int h = F.lane >> 3, d0 = (F.lane & 7) * 16;
    float sub[16];
#pragma unroll
    for (int e = 0; e < 16; ++e) sub[e] = subln[d0 + e] * (1.0f - LAM_INIT);
    for (int m = gw; m < M; m += NGW) {
        const GAS h8* p1 = (const GAS h8*)(O2 + (size_t)m * 2048 + (2 * h) * 128 + d0);
        const GAS h8* p2 = (const GAS h8*)(O2 + (size_t)m * 2048 + (2 * h + 1) * 128 + d0);
        const h8 a0 = p1[0], a1 = p1[1], b0 = p2[0], b1 = p2[1];
        float dl[16]; float ss = 0.f;
#pragma unroll
        for (int e = 0; e < 8; ++e) { dl[e] = (float)a0[e] - lam * (float)b0[e]; dl[8 + e] = (float)a1[e] - lam * (float)b1[e]; }
#pragma unroll
        for (int e = 0; e < 16; ++e) ss += dl[e] * dl[e];
        ss += __shfl_xor(ss, 1); ss += __shfl_xor(ss, 2); ss += __shfl_xor(ss, 4);
        const float r = 1.0f / sqrtf(ss * (1.0f / 128.0f) + NORM_EPS);
        v4u w0, w1;
        w0.x = pk2h(dl[0] * r * sub[0], dl[1] * r * sub[1]); w0.y = pk2h(dl[2] * r * sub[2], dl[3] * r * sub[3]); w0.z = pk2h(dl[4] * r * sub[4], dl[5] * r * sub[5]); w0.w = pk2h(dl[6] * r * sub[6], dl[7] * r * sub[7]);
        w1.x = pk2h(dl[8] * r * sub[8], dl[9] * r * sub[9]); w1.y = pk2h(dl[10] * r * sub[10], dl[11] * r * sub[11]); w1.z = pk2h(dl[12] * r * sub[12], dl[13] * r * sub[13]); w1.w = pk2h(dl[14] * r * sub[14], dl[15] * r * sub[15]);
        GAS v4u* o = (GAS v4u*)(A + (size_t)m * D + h * 128 + d0); o[0] = w0; o[1] = w1;
    }
}
__device__ __forceinline__ void kmean_phase(Frame& F, const f16* K, float* kmean) {
    const int gw = F.vcu * NWAVES + F.wave, NGW = F.G * NWAVES;
    for (int unit = gw; unit < 64 * 16; unit += NGW) { const int blk = unit >> 4, h = unit & 15;
        const f16* p = K + (size_t)(blk * 256) * D + h * 64 + F.lane; float s = 0.f;
#pragma unroll 8
        for (int r = 0; r < 256; ++r) s += (float)p[(size_t)r * D];
        kmean[(h * 64 + blk) * 64 + F.lane] = s * (1.0f / 256.0f); }
}
__device__ __forceinline__ void moba_naive(Frame& F, const f16* Q, const f16* K, const f16* V, const float* kmean, f16* O) {
    const int gw = F.vcu * NWAVES + F.wave, NGW = F.G * NWAVES, lane = F.lane;
    LAS float* pb = (LAS float*)(F.lds + RING_OFF + F.wave * 4608);
    LAS float* qf = pb + 1024;
    for (int unit = gw; unit < M * 16; unit += NGW) {
        const int q = unit >> 4, h = unit & 15, qblk = q >> 8;
        qf[lane] = (float)Q[(size_t)q * D + h * 64 + lane];
        LDS_WAIT(); asm volatile("" ::: "memory");
        float g = -INFINITY;
        if (lane < qblk) { const float* km = kmean + (h * 64 + lane) * 64; float a = 0.f;
#pragma unroll 4
            for (int d = 0; d < 64; d += 4) { const f32x4 kv = *(const f32x4*)(km + d); const f32x4 qv = *(const LAS f32x4*)(qf + d); a += kv.x * qv.x + kv.y * qv.y + kv.z * qv.z + kv.w * qv.w; }
            g = a; }
        int sel[3];
#pragma unroll
        for (int t = 0; t < 3; ++t) { float best = g; int bi = lane;
#pragma unroll
            for (int o = 1; o < 64; o <<= 1) { const float ov = __shfl_xor(best, o); const int oi = __shfl_xor(bi, o); if (ov > best || (ov == best && oi < bi)) { best = ov; bi = oi; } }
            sel[t] = __builtin_amdgcn_readfirstlane(bi); if (lane == sel[t]) g = -INFINITY; }
        const int nsel = qblk < 3 ? qblk : 3;
        float sc[16]; float mx = -INFINITY;
#pragma unroll
        for (int s = 0; s < 4; ++s) { const int blk = (s < 3) ? sel[s] : qblk; const bool valid = (s == 3) || (s < nsel);
#pragma unroll
            for (int i = 0; i < 4; ++i) { const int key = blk * 256 + i * 64 + lane; float a = -INFINITY;
                if (valid && key <= q) { const GAS h8* kp = (const GAS h8*)(K + (size_t)key * D + h * 64); a = 0.f;
#pragma unroll
                    for (int c = 0; c < 8; ++c) { const h8 kv = kp[c]; const f32x4 q0 = *(const LAS f32x4*)(qf + 8 * c), q1 = *(const LAS f32x4*)(qf + 8 * c + 4);
                        a += (float)kv[0] * q0.x + (float)kv[1] * q0.y + (float)kv[2] * q0.z + (float)kv[3] * q0.w + (float)kv[4] * q1.x + (float)kv[5] * q1.y + (float)kv[6] * q1.z + (float)kv[7] * q1.w; } }
                sc[s * 4 + i] = a; mx = fmaxf(mx, a); } }
        mx = wave_max(mx);
        float l = 0.f;
#pragma unroll
        for (int e = 0; e < 16; ++e) { const float p = __builtin_amdgcn_exp2f(sc[e] - mx); l += p; pb[e * 64 + lane] = p; }
        l = wave_sum(l);
        LDS_WAIT(); asm volatile("" ::: "memory");
        float o = 0.f;
#pragma unroll
        for (int s = 0; s < 4; ++s) { const int blk = (s < 3) ? sel[s] : qblk; const bool valid = (s == 3) || (s < nsel);
            if (valid) { const f16* vp = V + (size_t)(blk * 256) * D + h * 64 + lane; const LAS float* pp = pb + s * 256;
#pragma unroll 8
                for (int kk = 0; kk < 256; ++kk) o += pp[kk] * (float)vp[(size_t)kk * D]; } }
        O[(size_t)q * D + h * 64 + lane] = (f16)(o / l);
        LDS_WAIT(); asm volatile("" ::: "memory");
    }
}
struct AttnOrder {
    int vcu, G;
    __device__ __forceinline__ bool next(int i, int& head, int& qb) const {
        if (G == 256) { if (i >= 8) return false; const int s = vcu & 7, k = i >> 1; head = vcu >> 3; qb = (i & 1) ? (16 * k + 15 - s) : (16 * k + s); return true; }
        const int uix = i * G + vcu; if (uix >= 2048) return false; head = uix >> 6; qb = 63 - (uix & 63); return true;
    }
};

constexpr int NPHASE = 24;
struct Args { const float* in[13]; float* out; unsigned char* ws; int ph_lo, ph_hi; };
static_assert(sizeof(Args) == 15 * 8 + 8, "Args has no padding");
__global__ void __launch_bounds__(NWAVES * 64, 2) yoco_fwd(Args args) {
    extern __shared__ __attribute__((aligned(16))) unsigned char lds[];
    Frame F;
    F.lds = (LAS unsigned char*)lds;
    F.MISC = (volatile LAS unsigned*)(F.lds + MISC_OFF);
    F.tid = threadIdx.x; F.lane = F.tid & 63; F.wave = __builtin_amdgcn_readfirstlane(F.tid >> 6);
    F.G = gridDim.x; { const int bx = blockIdx.x; F.vcu = (F.G % 8 == 0) ? (bx % 8) * (F.G / 8) + bx / 8 : bx; }
    unsigned char* ws = args.ws;
    F.ctl = (gu32*)(ws + WS_CTL);
    for (int u = F.tid; u < (LDS_BYTES - LDSCTL_OFF) / 4; u += NWAVES * 64) ((LAS unsigned*)(F.lds + LDSCTL_OFF))[u] = 0u;
    __syncthreads();
    const int lo = args.ph_lo, hi = args.ph_hi;
    const bool one_launch = (hi - lo) > 1;
    XcdBarrier bar; bar.bar = (unsigned*)(F.ctl + CW_BAR); bar.x = 0; bar.st = nullptr;
    if (one_launch) bar = xcd_barrier_post((unsigned*)(F.ctl + CW_BAR), F.MISC + 8);
#define IN(k) (lo <= (k) && (k) < hi)
#define SEAM(k) do { if (IN(k) && IN((k) + 1)) xcd_barrier(bar); } while (0)

    const float* x_in = args.in[0]; const float* ffn_norm = args.in[1]; const float* mix_norm = args.in[4];
    float* X = args.out;
    f16* XN = (f16*)(ws + WS_XN); float* Y = (float*)(ws + WS_Y); f16* HB = (f16*)(ws + WS_A4);
    const float* rope = (const float*)(ws + WS_ROPE); float* kmean = (float*)(ws + WS_KMEAN);
    f16* A1a = (f16*)(ws + WS_A1); f16* A1b = (f16*)(ws + WS_A1 + ACT);
    typedef pg8::bf16_t hb;

#define FFN_PHASES(P, f, XIN, WANT_XN) \
    if (IN(P)) { pg8::Gemm g{(const hb*)XN, (const hb*)(ws + WS_WIN + (size_t)(f) * W_IN_SZ), M, NUP, D}; pg8::StaticOrder S; S.init(M, NUP, F.G, (int)blockIdx.x); \
        pg8::EpiSwiglu E{(hb*)HB, FF}; pg8::gemm_phase<pg8::EpiSwiglu, pg8::StaticOrder, true, true>(F.lds + RING_OFF, g, S, E); } SEAM(P); \
    if (IN((P) + 1)) { pg8::Gemm g{(const hb*)HB, (const hb*)(ws + WS_WOUT + (size_t)(f) * W_OUT_SZ), M, D, FF}; pg8::StaticOrder S; S.init(M, D, F.G, (int)blockIdx.x); \
        pg8::EpiF32 E{Y, D}; pg8::gemm_phase<pg8::EpiF32, pg8::StaticOrder, true, true>(F.lds + RING_OFF, g, S, E); } SEAM((P) + 1); \
    if (IN((P) + 2)) { norm_phase(F, (XIN), Y, ffn_norm + ((f) * 2 + 1) * D, 0.5f, X, (WANT_XN) ? XN : nullptr); } SEAM((P) + 2);

    if (IN(0)) { p0_prologue(F, args.in, ws); } SEAM(0);
    FFN_PHASES(1, 0, x_in, true)
    if (IN(4)) {
        pg8::Gemm g{(const hb*)XN, (const hb*)(ws + WS_WQKV), M, 3 * D, D}; pg8::StaticOrder S; S.init(M, 3 * D, F.G, (int)blockIdx.x);
        pg8::EpiRope3 E{(hb*)A1a, (size_t)M * D, 3u, C2, rope, D};
        pg8::gemm_phase<pg8::EpiRope3, pg8::StaticOrder, true, true>(F.lds + RING_OFF, g, S, E); } SEAM(4);
    if (IN(5)) {
        const AttnOrder S{F.vcu, F.G}; int head, qb;
        const f16* Qp = A1a; const f16* Kp = A1b; const f16* Vp = (const f16*)(ws + WS_Y); f16* O2 = (f16*)(ws + WS_A4);
        for (int i = 0; S.next(i, head, qb); ++i) { const int j = head >> 1, c = head & 1;
            attn_body::attn_unit<8, 2048>(qb, Qp + j * 64, Kp + j * 64, Vp + (j >> 1) * 128 + c * 64, O2 + j * 128 + c * 64, (char*)lds + RING_OFF); } } SEAM(5);
    if (IN(6)) { diff_combine(F, (const f16*)(ws + WS_A4), args.in[6], args.in[7], A1a); } SEAM(6);
    if (IN(7)) { pg8::Gemm g{(const hb*)A1a, (const hb*)(ws + WS_WOD), M, D, D}; pg8::StaticOrder S; S.init(M, D, F.G, (int)blockIdx.x);
        pg8::EpiF32 E{Y, D}; pg8::gemm_phase<pg8::EpiF32, pg8::StaticOrder, true, true>(F.lds + RING_OFF, g, S, E); } SEAM(7);
    if (IN(8)) { norm_phase(F, X, Y, mix_norm + 1 * D, 1.0f, X, XN); } SEAM(8);
    FFN_PHASES(9, 1, X, true)
    if (IN(12)) {
        pg8::Gemm g{(const hb*)XN, (const hb*)(ws + WS_WKV), M, 2 * D, D}; pg8::StaticOrder S; S.init(M, 2 * D, F.G, (int)blockIdx.x);
        pg8::EpiRope3 E{(hb*)A1a, (size_t)M * D, 1u, 1.0f, rope, D};
        pg8::gemm_phase<pg8::EpiRope3, pg8::StaticOrder, true, true>(F.lds + RING_OFF, g, S, E); } SEAM(12);
    if (IN(13)) { kmean_phase(F, A1a, kmean); } SEAM(13);
    FFN_PHASES(14, 2, X, true)
    if (IN(17)) {
        pg8::Gemm g{(const hb*)XN, (const hb*)(ws + WS_WQM), M, D, D}; pg8::StaticOrder S; S.init(M, D, F.G, (int)blockIdx.x);
        pg8::EpiRope3 E{(hb*)(ws + WS_A4), (size_t)0, 1u, C2, rope, D};
        pg8::gemm_phase<pg8::EpiRope3, pg8::StaticOrder, true, true>(F.lds + RING_OFF, g, S, E); } SEAM(17);
    if (IN(18)) { moba_naive(F, (const f16*)(ws + WS_A4), A1a, A1b, kmean, (f16*)(ws + WS_A4 + ACT)); } SEAM(18);
    if (IN(19)) { pg8::Gemm g{(const hb*)(ws + WS_A4 + ACT), (const hb*)(ws + WS_WOM), M, D, D}; pg8::StaticOrder S; S.init(M, D, F.G, (int)blockIdx.x);
        pg8::EpiF32 E{Y, D}; pg8::gemm_phase<pg8::EpiF32, pg8::StaticOrder, true, true>(F.lds + RING_OFF, g, S, E); } SEAM(19);
    if (IN(20)) { norm_phase(F, X, Y, mix_norm + 3 * D, 1.0f, X, XN); } SEAM(20);
    FFN_PHASES(21, 3, X, false)
#undef FFN_PHASES
#undef IN
#undef SEAM
}

extern "C" void kernel_launch(void* const* d_in, const int* in_sizes, int n_in, void* d_out, int out_size, void* d_ws, size_t ws_size, hipStream_t stream) {
    static int grid = 0;
    if (grid == 0) {
        if (n_in != 13 || in_sizes[0] != M * D || out_size != M * D || ws_size < WS_END) { fprintf(stderr, "kernel_launch: unexpected shapes / workspace (n_in %d, in0 %d, out %d, ws %zu < %zu); nothing launched\n", n_in, n_in > 0 ? in_sizes[0] : -1, out_size, ws_size, (size_t)WS_END); grid = -1; return; }
        int dev = 0, cus = 0, per_cu = 0;
        if (hipGetDevice(&dev) != hipSuccess || hipDeviceGetAttribute(&cus, hipDeviceAttributeMultiprocessorCount, dev) != hipSuccess) { grid = -1; return; }
        if (hipFuncSetAttribute((const void*)yoco_fwd, hipFuncAttributeMaxDynamicSharedMemorySize, LDS_BYTES) != hipSuccess) { fprintf(stderr, "kernel_launch: hipFuncSetAttribute failed\n"); grid = -1; return; }
        if (hipOccupancyMaxActiveBlocksPerMultiprocessor(&per_cu, (const void*)yoco_fwd, NWAVES * 64, LDS_BYTES) != hipSuccess || per_cu < 1) fprintf(stderr, "kernel_launch: occupancy query reports %d workgroups per CU\n", per_cu);
        (void)hipGetLastError();
        grid = cus;
    }
    if (grid < 0) return;
    if (hipMemsetAsync((char*)d_ws + WS_CTL, 0, CTL_ZERO_BYTES, stream) != hipSuccess) return;
    Args a{};
    for (int i = 0; i < 13; ++i) a.in[i] = (const float*)d_in[i];
    a.out = (float*)d_out; a.ws = (unsigned char*)d_ws;
#if MK_N_LAUNCHES == 1
    a.ph_lo = 0; a.ph_hi = NPHASE;
    hipLaunchKernelGGL(yoco_fwd, dim3(grid), dim3(NWAVES * 64), LDS_BYTES, stream, a);
#else
    for (int p = 0; p < NPHASE; ++p) { a.ph_lo = p; a.ph_hi = p + 1; hipLaunchKernelGGL(yoco_fwd, dim3(grid), dim3(NWAVES * 64), LDS_BYTES, stream, a); }
#endif
}
```

```cpp
#include <hip/hip_runtime.h>
#include <cstdio>
#include <cstdint>
#include <cmath>
namespace pg8 {
#define PG8_LAS __attribute__((address_space(3)))
typedef unsigned short bf16_t;
typedef short bf16x8 __attribute__((ext_vector_type(8)));
typedef _Float16 h8 __attribute__((ext_vector_type(8)));
typedef _Float16 h2 __attribute__((ext_vector_type(2)));
typedef float f32x4 __attribute__((ext_vector_type(4)));
typedef unsigned u32x4 __attribute__((ext_vector_type(4)));
constexpr int BM = 256, BK = 64, HALF = 128, HTB = HALF * BK * 2  , STAGE_BYTES = 8 * HTB, NXCD = 8, WGM = 8;

__host__ __device__ __forceinline__ int lds_byte(int r, int c) { const int st = (r >> 4) * 2 + (c >> 5), rr = r & 15, cc = c & 31, ob = rr * 64 + cc * 2; return st * 1024 + (ob ^ (((ob >> 9) & 1) << 5)); }
__host__ __device__ __forceinline__ void stage_rc(int b, int& R, int& C) { const int st = b / 1024, sb = b % 1024, swz = sb ^ (((sb >> 9) & 1) << 5); R = (st >> 1) * 16 + swz / 64; C = (st & 1) * 32 + (swz % 64) / 2; }
__host__ __device__ __forceinline__ int perm32(int rho) { const int n = rho >> 4, i = rho & 15; return 8 * (i >> 2) + 4 * n + (i & 3); }

struct Unit { int pm, pn; };
struct Gemm { const bf16_t* A; const bf16_t* Bt; int M, N, K; };

struct StaticOrder {
    int nM, nN, nwg, G, c;
    __host__ __device__ void init(int M, int N, int G_, int c_) { nM = M / BM; nN = N / BM; nwg = nM * nN; G = G_; c = c_; }
    __host__ __device__ bool next(int i, Unit& u) const {
        const long L = (long)i * G + c; if (L >= nwg) return false;
        int wgid = (int)L; { const int q = nwg / NXCD, r = nwg % NXCD, xcd = wgid % NXCD, off = wgid / NXCD; wgid = (xcd < r ? xcd * (q + 1) : r * (q + 1) + (xcd - r) * q) + off; }
        const int nig = WGM * nN, gid = wgid / nig, fm = gid * WGM, gsz = (nM - fm) < WGM ? (nM - fm) : WGM;
        u.pm = fm + ((wgid % nig) % gsz); u.pn = (wgid % nig) / gsz; return true;
    }
    __device__ __forceinline__ void a_ready(const Unit&) const {}
    __device__ __forceinline__ void done(const Unit&) const {}
};
typedef float f32x2 __attribute__((ext_vector_type(2)));
typedef unsigned u32x2 __attribute__((ext_vector_type(2)));
__device__ __forceinline__ unsigned cvt_pk_f16(float lo, float hi) { const f32x2 v = {lo, hi}; return __builtin_bit_cast(unsigned, __builtin_convertvector(v, h2)); }
struct EpiF32 {
    static constexpr bool PERM = false, AFTER_DRAIN = false;
    float* C; int ldc;
    __device__ __forceinline__ void operator()(const f32x4 (&acc)[2][2][4][2], const Unit& u, int wr, int wc, int fr, int fq) const {
        const int row0 = u.pm * BM + wr * 64 + fr, col0 = u.pn * BM + wc * 32 + 4 * fq;
#pragma unroll
        for (int ai = 0; ai < 2; ++ai)
#pragma unroll
            for (int m = 0; m < 4; ++m) { float* rowp = C + (size_t)(row0 + ai * HALF + m * 16) * ldc + col0;
#pragma unroll
                for (int bj = 0; bj < 2; ++bj)
#pragma unroll
                    for (int n = 0; n < 2; ++n) *(f32x4*)(rowp + bj * HALF + n * 16) = acc[ai][bj][m][n]; }
    }
};
struct EpiSwiglu {
    static constexpr bool PERM = true, AFTER_DRAIN = false;
    bf16_t* H; int ldh;
    __device__ __forceinline__ void operator()(const f32x4 (&acc)[2][2][4][2], const Unit& u, int wr, int wc, int fr, int fq) const {
        const int row0 = u.pm * BM + wr * 64 + fr, hc0 = u.pn * (BM / 2) + wc * 16 + 4 * fq;
#pragma unroll
        for (int ai = 0; ai < 2; ++ai)
#pragma unroll
            for (int m = 0; m < 4; ++m) { bf16_t* rowp = H + (size_t)(row0 + ai * HALF + m * 16) * ldh + hc0;
#pragma unroll
                for (int bj = 0; bj < 2; ++bj) { const f32x4 g = acc[ai][bj][m][0], up = acc[ai][bj][m][1]; float s[4];
#pragma unroll
                    for (int e = 0; e < 4; ++e) { const float ex = __builtin_amdgcn_exp2f(g[e] * -1.4426950408889634f); s[e] = g[e] * __builtin_amdgcn_rcpf(1.0f + ex) * up[e]; }
                    u32x2 w; w.x = cvt_pk_f16(s[0], s[1]); w.y = cvt_pk_f16(s[2], s[3]);
                    *(u32x2*)(rowp + bj * (HALF / 2)) = w; } }
    }
};
struct EpiRope3 {
    static constexpr bool PERM = true, AFTER_DRAIN = false;
    bf16_t* out0; size_t split_stride; unsigned ropemask; float scale0; const float* rope; int ldc;
    __device__ __forceinline__ void operator()(const f32x4 (&acc)[2][2][4][2], const Unit& u, int wr, int wc, int fr, int fq) const {
        const int t = (u.pn * BM) >> 10, colt = u.pn * BM - (t << 10); bf16_t* base = out0 + (size_t)t * split_stride;
        const float sc = (t == 0) ? scale0 : 1.0f; const bool dorope = ((ropemask >> t) & 1u) != 0u;
        const int row0 = u.pm * BM + wr * 64 + fr, col0 = colt + wc * 32 + 8 * fq;
#pragma unroll
        for (int ai = 0; ai < 2; ++ai)
#pragma unroll
            for (int m = 0; m < 4; ++m) { const int row = row0 + ai * HALF + m * 16; bf16_t* rowp = base + (size_t)row * ldc + col0;
#pragma unroll
                for (int bj = 0; bj < 2; ++bj) { f32x4 v0 = acc[ai][bj][m][0], v1 = acc[ai][bj][m][1];
                    if (dorope) { const int i0 = ((col0 + bj * HALF) & 63) >> 1; const float* rp = rope + ((size_t)row * 32 + i0) * 2;
                        const f32x4 c0 = *(const f32x4*)rp, c1 = *(const f32x4*)(rp + 4);
                        f32x4 r0, r1;
                        r0[0] = v0[0] * c0[0] - v0[1] * c0[1]; r0[1] = v0[1] * c0[0] + v0[0] * c0[1]; r0[2] = v0[2] * c0[2] - v0[3] * c0[3]; r0[3] = v0[3] * c0[2] + v0[2] * c0[3];
                        r1[0] = v1[0] * c1[0] - v1[1] * c1[1]; r1[1] = v1[1] * c1[0] + v1[0] * c1[1]; r1[2] = v1[2] * c1[2] - v1[3] * c1[3]; r1[3] = v1[3] * c1[2] + v1[2] * c1[3];
                        v0 = r0; v1 = r1; }
                    v0 = v0 * sc; v1 = v1 * sc; u32x4 w; w.x = cvt_pk_f16(v0[0], v0[1]); w.y = cvt_pk_f16(v0[2], v0[3]); w.z = cvt_pk_f16(v1[0], v1[1]); w.w = cvt_pk_f16(v1[2], v1[3]);
                    *(u32x4*)(rowp + bj * HALF) = w; } }
    }
};

template <class Epi, class Sched, bool ALIGN_EPI = false, bool SP2 = false>
__device__ __forceinline__ void gemm_phase(PG8_LAS unsigned char* lds, const Gemm g, const Sched& S, const Epi& E) {
    const int tid = threadIdx.x, wid = __builtin_amdgcn_readfirstlane(tid >> 6), lane = tid & 63, wr = wid >> 2, wc = wid & 3, fr = lane & 15, fq = lane >> 4;
    const int K = g.K, nt = K / BK;
    unsigned voffA[2], voffB[2];
#pragma unroll
    for (int i = 0; i < 2; ++i) { int R, C; stage_rc(tid * 16 + i * 8192, R, C); const int Rb = Epi::PERM ? ((R & ~31) + perm32(R & 31)) : R;
        voffA[i] = (unsigned)(R * K + C) * 2u; voffB[i] = (unsigned)(Rb * K + C) * 2u; }
    const size_t kstep = (size_t)(BK * 2);
    const size_t hstep = (size_t)HALF * K * 2;
    const size_t tstep = 2 * hstep;
    const unsigned ldsw = (unsigned)wid * 1024u;
    const int aoff = lds_byte(wr * 64 + fr, fq * 8), boff = lds_byte(wc * 32 + fr, fq * 8);
#define PG8_SA(b, h) (((b) * 2 + (h)) * HTB)
#define PG8_SB(b, h) ((4 + (b) * 2 + (h)) * HTB)
#define PG8_STAGE(bufoff, gbase, voff) do { _Pragma("unroll") for (int _i = 0; _i < 2; ++_i) \
        __builtin_amdgcn_global_load_lds((const unsigned*)((const char*)(gbase) + (voff)[_i]), (PG8_LAS unsigned*)(lds + (bufoff) + ldsw + _i * 8192), 16, 0, 0); } while (0)
#define PG8_LDA(dst, b, h) do { _Pragma("unroll") for (int m = 0; m < 4; ++m) _Pragma("unroll") for (int k = 0; k < 2; ++k) dst[m][k] = *(const PG8_LAS h8*)(lds + PG8_SA(b, h) + aoff + m * 2048 + k * 1024); } while (0)
#define PG8_LDB(dst, b, h) do { _Pragma("unroll") for (int n = 0; n < 2; ++n) _Pragma("unroll") for (int k = 0; k < 2; ++k) dst[n][k] = *(const PG8_LAS h8*)(lds + PG8_SB(b, h) + boff + n * 2048 + k * 1024); } while (0)
#define PG8_MMA(ai, bj, At, Bt) do { __builtin_amdgcn_s_setprio(1); _Pragma("unroll") for (int m = 0; m < 4; ++m) _Pragma("unroll") for (int n = 0; n < 2; ++n) _Pragma("unroll") for (int k = 0; k < 2; ++k) \
        acc[ai][bj][m][n] = __builtin_amdgcn_mfma_f32_16x16x32_f16(Bt[n][k], At[m][k], acc[ai][bj][m][n], 0, 0, 0); __builtin_amdgcn_s_setprio(0); } while (0)
#define PG8_WAIT_V(n) asm volatile("s_waitcnt vmcnt(" #n ")" ::: "memory")
#define PG8_WAIT_L(n) asm volatile("s_waitcnt lgkmcnt(" #n ")" ::: "memory")
#define PG8_BAR __builtin_amdgcn_s_barrier()
#define PG8_SCHED __builtin_amdgcn_sched_barrier(0)
    Unit cur, nxt; int ui = 0;
    if (!S.next(0, cur)) return;
    f32x4 acc[2][2][4][2];
#pragma unroll
    for (int a = 0; a < 2; ++a)
#pragma unroll
        for (int b = 0; b < 2; ++b)
#pragma unroll
            for (int m = 0; m < 4; ++m)
#pragma unroll
                for (int n = 0; n < 2; ++n) acc[a][b][m][n] = (f32x4){0.f, 0.f, 0.f, 0.f};
    h8 At[4][2], B0[2][2], B1[2][2];
    const char* cA = (const char*)g.A + (size_t)cur.pm * tstep; const char* cB = (const char*)g.Bt + (size_t)cur.pn * tstep;
    S.a_ready(cur);
    if constexpr (SP2) {
        PG8_STAGE(PG8_SB(0, 0), cB, voffB); PG8_STAGE(PG8_SB(0, 1), cB + hstep, voffB); PG8_STAGE(PG8_SA(0, 0), cA, voffA); PG8_STAGE(PG8_SA(0, 1), cA + hstep, voffA);
        if (wr == 1) PG8_BAR;
        PG8_WAIT_V(2); PG8_BAR;
        PG8_STAGE(PG8_SB(1, 0), cB + kstep, voffB); PG8_STAGE(PG8_SA(1, 0), cA + kstep, voffA); PG8_STAGE(PG8_SB(1, 1), cB + hstep + kstep, voffB);
        PG8_WAIT_V(6); PG8_BAR;
    } else {
        PG8_STAGE(PG8_SB(0, 0), cB, voffB); PG8_STAGE(PG8_SA(0, 0), cA, voffA); PG8_STAGE(PG8_SB(0, 1), cB + hstep, voffB); PG8_STAGE(PG8_SA(0, 1), cA + hstep, voffA);
        if (wr == 1) PG8_BAR;
        PG8_WAIT_V(4); PG8_BAR;
        PG8_STAGE(PG8_SB(1, 0), cB + kstep, voffB); PG8_STAGE(PG8_SA(1, 0), cA + kstep, voffA); PG8_STAGE(PG8_SB(1, 1), cB + hstep + kstep, voffB);
        PG8_WAIT_V(6); PG8_BAR;
    }
    for (;;) {
        const bool has_next = S.next(ui + 1, nxt);
        const char* nA = has_next ? (const char*)g.A + (size_t)nxt.pm * tstep : cA; const char* nB = has_next ? (const char*)g.Bt + (size_t)nxt.pn * tstep : cB;
        for (int t = 0; t < nt; t += 2) {
            const bool last = (t == nt - 2);
            const char* a1 = cA + (size_t)(t + 1) * kstep;
            const char* a2 = last ? nA : cA + (size_t)(t + 2) * kstep; const char* b2 = last ? nB : cB + (size_t)(t + 2) * kstep;
            const char* a3 = a2 + kstep; const char* b3 = b2 + kstep;
            if (last && has_next) S.a_ready(nxt);
            if constexpr (SP2) {
            PG8_LDB(B0, 0, 0); PG8_LDB(B1, 0, 1); PG8_SCHED; PG8_LDA(At, 0, 0); PG8_STAGE(PG8_SA(1, 1), a1 + hstep, voffA);
            PG8_WAIT_V(8); PG8_WAIT_L(0); PG8_BAR; PG8_MMA(0, 0, At, B0); PG8_MMA(0, 1, At, B1); PG8_BAR; PG8_SCHED;
            PG8_LDA(At, 0, 1); PG8_STAGE(PG8_SB(0, 0), b2, voffB); PG8_STAGE(PG8_SB(0, 1), b2 + hstep, voffB); PG8_STAGE(PG8_SA(0, 0), a2, voffA);
            PG8_WAIT_V(8); PG8_WAIT_L(0); PG8_BAR; PG8_MMA(1, 0, At, B0); PG8_MMA(1, 1, At, B1); PG8_BAR; PG8_SCHED;
            PG8_LDB(B0, 1, 0); PG8_LDB(B1, 1, 1); PG8_SCHED; PG8_LDA(At, 1, 0); PG8_STAGE(PG8_SA(0, 1), a2 + hstep, voffA);
            PG8_WAIT_V(8); PG8_WAIT_L(0); PG8_BAR; PG8_MMA(0, 0, At, B0); PG8_MMA(0, 1, At, B1); PG8_BAR; PG8_SCHED;
            PG8_LDA(At, 1, 1); PG8_STAGE(PG8_SB(1, 0), b3, voffB); PG8_STAGE(PG8_SB(1, 1), b3 + hstep, voffB); PG8_STAGE(PG8_SA(1, 0), a3, voffA);
            PG8_WAIT_V(8); PG8_WAIT_L(0); PG8_BAR; PG8_MMA(1, 0, At, B0); PG8_MMA(1, 1, At, B1); PG8_BAR; PG8_SCHED;
            } else {
            PG8_LDB(B0, 0, 0); PG8_SCHED; PG8_LDA(At, 0, 0); PG8_STAGE(PG8_SA(1, 1), a1 + hstep, voffA);
            PG8_WAIT_L(8); PG8_BAR; PG8_WAIT_L(0); PG8_MMA(0, 0, At, B0); PG8_BAR; PG8_SCHED;
            PG8_LDB(B1, 0, 1); PG8_STAGE(PG8_SB(0, 0), b2, voffB);
            PG8_BAR; PG8_WAIT_L(0); PG8_MMA(0, 1, At, B1); PG8_BAR;
            PG8_LDA(At, 0, 1); PG8_STAGE(PG8_SA(0, 0), a2, voffA);
            PG8_BAR; PG8_WAIT_L(0); PG8_MMA(1, 0, At, B0); PG8_BAR; PG8_SCHED;
            PG8_STAGE(PG8_SB(0, 1), b2 + hstep, voffB);
            PG8_WAIT_V(6); PG8_BAR; PG8_MMA(1, 1, At, B1); PG8_BAR;
            PG8_LDB(B0, 1, 0); PG8_SCHED; PG8_LDA(At, 1, 0); PG8_STAGE(PG8_SA(0, 1), a2 + hstep, voffA);
            PG8_WAIT_L(8); PG8_BAR; PG8_WAIT_L(0); PG8_MMA(0, 0, At, B0); PG8_BAR; PG8_SCHED;
            PG8_LDB(B1, 1, 1); PG8_STAGE(PG8_SB(1, 0), b3, voffB);
            PG8_BAR; PG8_WAIT_L(0); PG8_MMA(0, 1, At, B1); PG8_BAR;
            PG8_LDA(At, 1, 1); PG8_STAGE(PG8_SA(1, 0), a3, voffA);
            PG8_BAR; PG8_WAIT_L(0); PG8_MMA(1, 0, At, B0); PG8_BAR; PG8_SCHED;
            PG8_STAGE(PG8_SB(1, 1), b3 + hstep, voffB);
            PG8_WAIT_V(6); PG8_BAR; PG8_MMA(1, 1, At, B1); PG8_BAR;
            }
        }
        if constexpr (ALIGN_EPI) { if (wr == 0) PG8_BAR; }
        if constexpr (!Epi::AFTER_DRAIN) { E(acc, cur, wr, wc, fr, fq); S.done(cur); }
        if (!has_next) break;
#pragma unroll
        for (int a = 0; a < 2; ++a)
#pragma unroll
            for (int b = 0; b < 2; ++b)
#pragma unroll
                for (int m = 0; m < 4; ++m)
#pragma unroll
                    for (int n = 0; n < 2; ++n) acc[a][b][m][n] = (f32x4){0.f, 0.f, 0.f, 0.f};
        cur = nxt; cA = nA; cB = nB; ++ui;
        if constexpr (ALIGN_EPI) { if (wr == 1) PG8_BAR; }
    }
    PG8_WAIT_V(0);
    if constexpr (!ALIGN_EPI) { if (wr == 0) PG8_BAR; }
    PG8_BAR;
    if constexpr (Epi::AFTER_DRAIN) { E.fused(acc, cur, wr, wc, fr, fq, lds, wid, lane); S.done(cur); }
#undef PG8_SA
#undef PG8_SB
#undef PG8_STAGE
#undef PG8_LDA
#undef PG8_LDB
#undef PG8_MMA
#undef PG8_WAIT_V
#undef PG8_WAIT_L
#undef PG8_BAR
#undef PG8_SCHED
}
}
namespace attn_body {
using bf16=_Float16;
using h8v=__attribute__((ext_vector_type(8)))_Float16;
using bf16x8=__attribute__((ext_vector_type(8)))short;
using s16x4=__attribute__((ext_vector_type(4)))short;
using f32x16=__attribute__((ext_vector_type(16)))float;
using u32x4=__attribute__((ext_vector_type(4)))unsigned;
constexpr int BATCH=1,NHEAD=16,SEQ=16384,D=64,DM=NHEAD*D;
constexpr int NW=8,QBLK=32,QB=QBLK*NW,KVBLK=64,NQB=SEQ/QB;
constexpr int ATTN_PITCH=DM, ATTN_UNIT_ROWS=QB;
__device__ __forceinline__ int crow(int r,int hi){return (r&3)+8*(r>>2)+4*hi;}
#define SBAR() __builtin_amdgcn_sched_barrier(0)
__device__ __forceinline__ f32x16 MF16(bf16x8 x,bf16x8 y,f32x16 c,int,int,int){return __builtin_amdgcn_mfma_f32_32x32x16_f16(__builtin_bit_cast(h8v,x),__builtin_bit_cast(h8v,y),c,0,0,0);}
__device__ __forceinline__ void cmask(f32x16&p0,f32x16&p1,int jb,int qrel,int hi){
  const float NEG=-INFINITY; int kb=64*jb+4*hi;
  #pragma unroll
  for(int r=0;r<16;++r){int kv=kb+(r&3)+8*(r>>2); if(kv>qrel)p0[r]=NEG; if(kv+32>qrel)p1[r]=NEG;}
}

constexpr int NSLOT=3, SLOTB=8192;
constexpr int LDS_K=0, LDS_V=NSLOT*SLOTB, LDS_WS=2*NSLOT*SLOTB, LDS_OST=LDS_WS+NW*64*4, LDS_BYTES=LDS_OST+NW*4096;
constexpr float C2=0.125f*1.4426950408889634f;
__device__ __forceinline__ void glds16(const void*gsrc,unsigned lds_dst){unsigned keep;
  asm volatile("s_mov_b32 %0, m0\n\ts_mov_b32 m0, %2\n\ts_nop 0\n\tglobal_load_lds_dwordx4 %1, off\n\ts_mov_b32 m0, %0":"=&s"(keep):"v"(gsrc),"s"(lds_dst):"memory");}
__device__ __forceinline__ float max3f(float a,float b,float c){float r;asm("v_max3_f32 %0, %1, %2, %3":"=v"(r):"v"(a),"v"(b),"v"(c));return r;}
__device__ __forceinline__ float max2f(float a,float b){float r;asm("v_max_f32_e32 %0, %1, %2":"=v"(r):"v"(a),"v"(b));return r;}
__device__ __forceinline__ float fadd_s(float a,float b){float r;asm("v_add_f32_e32 %0, %1, %2":"=v"(r):"v"(a),"v"(b));return r;}
__device__ __forceinline__ float fsub_s(float a,float b){float r;asm("v_sub_f32_e32 %0, %1, %2":"=v"(r):"v"(a),"v"(b));return r;}
typedef float f32x2_t __attribute__((ext_vector_type(2))); typedef _Float16 bf16x2_t __attribute__((ext_vector_type(2)));
__device__ __forceinline__ unsigned cvtpk_s(float lo,float hi){f32x2_t v={lo,hi};bf16x2_t b=__builtin_convertvector(v,bf16x2_t);return __builtin_bit_cast(unsigned,b);}
#define WAIT_BAR(N) asm volatile("s_waitcnt vmcnt(" #N ") lgkmcnt(0)\n\ts_barrier":::"memory")

__device__ __forceinline__ void qkt(f32x16&p0,f32x16&p1,const char*Kslot,const bf16x8*qr,const f32x16&negm,int r32,int hi){
  const char*kb=Kslot+hi*1024+r32*16;
  #pragma unroll
  for(int d0=0;d0<4;++d0){
    const bf16x8 b0=*reinterpret_cast<const bf16x8*>(kb+d0*2048);
    const bf16x8 b1=*reinterpret_cast<const bf16x8*>(kb+d0*2048+512);
    if(d0==0){p0=MF16(b0,qr[0],negm,0,0,0);p1=MF16(b1,qr[0],negm,0,0,0);}
    else{p0=MF16(b0,qr[d0],p0,0,0,0);p1=MF16(b1,qr[d0],p1,0,0,0);}}
}
typedef __attribute__((address_space(3))) const char* lds_cptr;
typedef short v4i16_t __attribute__((ext_vector_type(4)));
__device__ __forceinline__ void kload8(bf16x8*kf,lds_cptr kp){
  kf[0]=*(const __attribute__((address_space(3))) bf16x8*)(kp);      kf[1]=*(const __attribute__((address_space(3))) bf16x8*)(kp+512);
  kf[2]=*(const __attribute__((address_space(3))) bf16x8*)(kp+2048); kf[3]=*(const __attribute__((address_space(3))) bf16x8*)(kp+2560);
  kf[4]=*(const __attribute__((address_space(3))) bf16x8*)(kp+4096); kf[5]=*(const __attribute__((address_space(3))) bf16x8*)(kp+4608);
  kf[6]=*(const __attribute__((address_space(3))) bf16x8*)(kp+6144); kf[7]=*(const __attribute__((address_space(3))) bf16x8*)(kp+6656);
}
__device__ __forceinline__ void kload2(bf16x8*kf,lds_cptr kp,int j){ kf[2*j]=*(const __attribute__((address_space(3))) bf16x8*)(kp+j*2048); kf[2*j+1]=*(const __attribute__((address_space(3))) bf16x8*)(kp+j*2048+512); }
__device__ __forceinline__ s16x4 vtr(lds_cptr p){ return __builtin_bit_cast(s16x4,__builtin_amdgcn_ds_read_tr16_b64_v4i16((__attribute__((address_space(3))) v4i16_t*)p)); }
__device__ __forceinline__ float rowmax(const f32x16&p0,const f32x16&p1){
  float a=max3f(p0[0],p0[1],p1[0]),b=max3f(p0[2],p0[3],p1[1]);a=max3f(a,p1[2],p1[3]);
  #pragma unroll
  for(int r=4;r<16;r+=4){a=max3f(a,p0[r],p0[r+1]);b=max3f(b,p0[r+2],p0[r+3]);a=max3f(a,p1[r],p1[r+1]);b=max3f(b,p1[r+2],p1[r+3]);}
  const float m=max2f(a,b);
  auto rr=__builtin_amdgcn_permlane32_swap(__float_as_uint(m),__float_as_uint(m),false,false);
  return max2f(__uint_as_float(rr[0]),__uint_as_float(rr[1]));
}
__device__ __forceinline__ void pv(f32x16*o,int vb,bf16x8 pa0,bf16x8 pa1,bf16x8 pa2,bf16x8 pa3){
  #pragma unroll
  for(int d0=0;d0<2;++d0){s16x4 lo[4],hi[4];
    #pragma unroll
    for(int ks=0;ks<4;++ks){
      asm volatile("ds_read_b64_tr_b16 %0,%1 offset:%c2":"=&v"(lo[ks]):"v"(vb),"i"(d0*4096+ks*1024):"memory");
      asm volatile("ds_read_b64_tr_b16 %0,%1 offset:%c2":"=&v"(hi[ks]):"v"(vb),"i"(d0*4096+ks*1024+512):"memory");}
    asm volatile("s_waitcnt lgkmcnt(0)":::"memory");SBAR();
    #define PK(k) (bf16x8){lo[k][0],lo[k][1],lo[k][2],lo[k][3],hi[k][0],hi[k][1],hi[k][2],hi[k][3]}
    o[d0]=MF16(pa0,PK(0),o[d0],0,0,0);
    o[d0]=MF16(pa1,PK(1),o[d0],0,0,0);
    o[d0]=MF16(pa2,PK(2),o[d0],0,0,0);
    o[d0]=MF16(pa3,PK(3),o[d0],0,0,0);
    #undef PK
  }
}

#ifndef ATTN_STORE16
#define ATTN_STORE16(p,v) (*(u32x4*)(p)=(v))
#endif
template<int THRL,int OP> __device__ __forceinline__ void attn_unit(int qb,const bf16*Qh,const bf16*__restrict__ Kh,const bf16*__restrict__ Vh,bf16*Oh,char*shm){
  int tid_=threadIdx.x; asm volatile("":"+v"(tid_));
  const int tid=tid_,lane=tid&63,r32=lane&31,hi=lane>>5; const int wid=__builtin_amdgcn_readfirstlane(tid>>6);
  const int q0=qb*QB;
  const bf16*Qw=Qh+(long)(q0+wid*QBLK)*DM;
  const unsigned lds0=(unsigned)(uintptr_t)shm;
  float*wsf=(float*)(shm+LDS_WS)+wid*64;
  const bf16*ksrc=Kh+(long)lane*DM+wid*8;
  const bf16*vsrc=Vh+(long)(16*(wid&3)+(lane>>2))*DM+(wid>>2)*32+(lane&3)*8;
  const unsigned kdst=lds0+LDS_K+wid*1024, vdst=lds0+LDS_V+wid*1024;
  #define DMA_K(t,slot) glds16(ksrc+(long)(t)*KVBLK*DM,(unsigned)__builtin_amdgcn_readfirstlane(kdst+(slot)))
  #define DMA_V(t,slot) glds16(vsrc+(long)(t)*KVBLK*DM,(unsigned)__builtin_amdgcn_readfirstlane(vdst+(slot)))
  const int vb0=(int)(lds0+LDS_V)+((lane>>4)&1)*32+(lane&3)*8+(4*hi+((lane&15)>>2))*64;
  const char*Kbase=shm+LDS_K; bf16x8 kf[8];
  const lds_cptr shm3=(lds_cptr)shm; const lds_cptr kp0=shm3+LDS_K+hi*1024+r32*16; const lds_cptr vp0=shm3+LDS_V+((lane>>4)&1)*32+(lane&3)*8+(4*hi+((lane&15)>>2))*64;
  const int NT=(q0+QB)/KVBLK;
  DMA_K(0,0);DMA_V(0,0);DMA_K(1,SLOTB);
  bf16x8 qr[4];
  #pragma unroll
  for(int d0=0;d0<4;++d0)qr[d0]=*reinterpret_cast<const bf16x8*>(&Qw[(long)r32*DM+d0*16+hi*8]);
  float mhat=0.f,l_reg=0.f;f32x16 o[2];o[0]=f32x16{};o[1]=f32x16{};f32x16 negm=f32x16{};asm volatile("":"+v"(negm));
  const int qrel=wid*QBLK+r32;
  #define CMASK(P0,P1,t) do{int jb_=(t)-(NT-4); if(jb_>=0)cmask(P0,P1,jb_,qrel,hi);}while(0)
  bool resc=false;
  #define START(P0,P1) do{ const float rm=rowmax(P0,P1); resc=false; \
    { const float dl=rm; mhat=fadd_s(mhat,dl); \
      _Pragma("unroll") for(int r=0;r<16;++r){P0[r]=fsub_s(P0[r],dl);P1[r]=fsub_s(P1[r],dl);} \
      _Pragma("unroll") for(int r=0;r<16;++r)negm[r]=-mhat; asm volatile("":"+v"(negm)); } \
    _Pragma("unroll") for(int r=0;r<16;++r)P0[r]=__builtin_amdgcn_exp2f(P0[r]); }while(0)
  #define RESC() do{ if(resc){ asm volatile("s_waitcnt lgkmcnt(0)":::"memory"); \
      _Pragma("unroll") for(int d_=0;d_<2;++d_) _Pragma("unroll") for(int r=0;r<16;++r)o[d_][r]*=wsf[crow(r,hi)]; } }while(0)
  f32x16 pA0,pA1,pB0,pB1;
  int sl_prev=0,sl_cur=0,sl_next=SLOTB;
  #define ROT() do{sl_prev=sl_cur;sl_cur=sl_next;sl_next=(sl_next==(NSLOT-1)*SLOTB)?0:sl_next+SLOTB;}while(0)
  DMA_K(2,2*SLOTB);
  WAIT_BAR(3);
  qkt(pA0,pA1,Kbase,qr,negm,r32,hi);asm volatile("s_nop 15\n\ts_nop 7":"+v"(pA0),"+v"(pA1));CMASK(pA0,pA1,0);
  START(pA0,pA1);
  _Pragma("unroll") for(int r=0;r<16;++r)pA1[r]=__builtin_amdgcn_exp2f(pA1[r]);
  WAIT_BAR(0);
  DMA_K(3,0);DMA_V(1,SLOTB);
  ROT();
  kload8(kf,kp0+sl_cur);
  WAIT_BAR(2);
  s16x4 vlo[8],vhi[8]; u32x4 pw0,pw1,pw2,pw3;
  #define PKW(P,B) cvtpk_s(P[B],P[B+1])
  #define PAF(k) __builtin_bit_cast(bf16x8,pw##k)
  #define VFR(i) (bf16x8){vlo[i][0],vlo[i][1],vlo[i][2],vlo[i][3],vhi[i][0],vhi[i][1],vhi[i][2],vhi[i][3]}
  #define PIN(x) asm volatile("":"+v"(x))
  #define MX3(a,b,c) __builtin_fmaxf(__builtin_fmaxf((a),(b)),(c))
  #define GAPA(MF,A0,A1,A2,A3,W0,W1,PW) do{ MF; sacc+=A0; sacc+=A1; sacc+=A2; sacc+=A3; PIN(sacc); W0; W1; PIN(PW); SBAR(); }while(0)
  #define EX(v) __builtin_amdgcn_exp2f(v)
  #define GAPB(MF,X,B) do{ MF; X[B]=EX(X[B]); X[B+1]=EX(X[B+1]); X[B+2]=EX(X[B+2]); X[B+3]=EX(X[B+3]); PIN(X); SBAR(); }while(0)
  #define VRD(i) do{ vlo[i]=vtr(vp_+(((i)>>2)*4096+((i)&3)*1024)); vhi[i]=vtr(vp_+(((i)>>2)*4096+((i)&3)*1024+512)); }while(0)
  #define KRD(G,j) do{ if(G){ kload2(kf,kp0+sl_next,j); SBAR(); } }while(0)
  #define STEP(C0,C1,P0,P1,t,GK,GV,GL) do{ SBAR(); \
    const lds_cptr vp_=vp0+sl_prev; \
    VRD(0); SBAR(); float sacc=(P0[0]+P0[1]); \
    GAPA(C0=MF16(kf[0],qr[0],negm,0,0,0), P0[2],P0[3],P0[4],P0[5],     pw0[0]=PKW(P0,0), pw0[1]=PKW(P0,2), pw0); \
    VRD(4); SBAR(); GAPA(C1=MF16(kf[1],qr[0],negm,0,0,0), P0[6],P0[7],P0[8],P0[9],     pw0[2]=PKW(P0,4), pw0[3]=PKW(P0,6), pw0); \
    VRD(1); SBAR(); GAPA(C0=MF16(kf[2],qr[1],C0,0,0,0),   P0[10],P0[11],P0[12],P0[13], pw1[0]=PKW(P0,8), pw1[1]=PKW(P0,10), pw1); \
    VRD(5); SBAR(); GAPA(C1=MF16(kf[3],qr[1],C1,0,0,0),   P0[14],P0[15],P1[0],P1[1],   pw1[2]=PKW(P0,12),pw1[3]=PKW(P0,14), pw1); \
    VRD(2); SBAR(); GAPA(C0=MF16(kf[4],qr[2],C0,0,0,0),   P1[2],P1[3],P1[4],P1[5],     pw2[0]=PKW(P1,0), pw2[1]=PKW(P1,2), pw2); \
    VRD(6); SBAR(); GAPA(C1=MF16(kf[5],qr[2],C1,0,0,0),   P1[6],P1[7],P1[8],P1[9],     pw2[2]=PKW(P1,4), pw2[3]=PKW(P1,6), pw2); \
    VRD(3); SBAR(); GAPA(C0=MF16(kf[6],qr[3],C0,0,0,0),   P1[10],P1[11],P1[12],P1[13], pw3[0]=PKW(P1,8), pw3[1]=PKW(P1,10), pw3); \
    VRD(7); SBAR(); GAPA(C1=MF16(kf[7],qr[3],C1,0,0,0),   P1[14],P1[15],0.f,0.f,       pw3[2]=PKW(P1,12),pw3[3]=PKW(P1,14), pw3); \
    l_reg+=sacc; \
    if(GK){DMA_K((t)+3,sl_cur);} if(GV){DMA_V((t)+1,sl_next);} \
    CMASK(C0,C1,t); \
    { float a=MX3(C0[0],C0[1],C1[0]),b=MX3(C0[2],C0[3],C1[1]); a=MX3(a,C1[2],C1[3]); \
      _Pragma("unroll") for(int r=4;r<16;r+=4){a=MX3(a,C0[r],C0[r+1]);b=MX3(b,C0[r+2],C0[r+3]);a=MX3(a,C1[r],C1[r+1]);b=MX3(b,C1[r+2],C1[r+3]);} \
      float rm=__builtin_fmaxf(a,b); { auto rr=__builtin_amdgcn_permlane32_swap(__float_as_uint(rm),__float_as_uint(rm),false,false); rm=__builtin_fmaxf(__uint_as_float(rr[0]),__uint_as_float(rr[1])); } \
      resc=false; \
      if(__builtin_expect(__any(rm>(float)THRL),0)){ const float dl=__builtin_fmaxf(rm,0.f); mhat+=dl; \
        _Pragma("unroll") for(int r=0;r<16;++r){C0[r]-=dl;C1[r]-=dl;} \
        _Pragma("unroll") for(int r=0;r<16;++r)negm[r]=-mhat; asm volatile("":"+v"(negm)); \
        const float f=__builtin_amdgcn_exp2f(-dl); l_reg*=f; if(hi==0)wsf[r32]=f; resc=true; } } \
    SBAR(); \
    GAPB(o[0]=MF16(PAF(0),VFR(0),o[0],0,0,0), C0,0); \
    GAPB(o[1]=MF16(PAF(0),VFR(4),o[1],0,0,0), C0,4); \
    KRD(GL,0); GAPB(o[0]=MF16(PAF(1),VFR(1),o[0],0,0,0), C0,8); \
    KRD(GL,1); GAPB(o[1]=MF16(PAF(1),VFR(5),o[1],0,0,0), C0,12); \
    KRD(GL,2); GAPB(o[0]=MF16(PAF(2),VFR(2),o[0],0,0,0), C1,0); \
    KRD(GL,3); GAPB(o[1]=MF16(PAF(2),VFR(6),o[1],0,0,0), C1,4); \
    GAPB(o[0]=MF16(PAF(3),VFR(3),o[0],0,0,0), C1,8); \
    GAPB(o[1]=MF16(PAF(3),VFR(7),o[1],0,0,0), C1,12); \
    }while(0)
  int t=1;
  #undef CMASK
  #define CMASK(P0,P1,t) do{}while(0)
  for(;t+5<NT;t+=2){
    STEP(pB0,pB1,pA0,pA1,t,true,true,true);     WAIT_BAR(2); RESC(); ROT();
    STEP(pA0,pA1,pB0,pB1,t+1,true,true,true);   WAIT_BAR(2); RESC(); ROT();
  }
  #undef CMASK
  #define CMASK(P0,P1,t) do{int jb_=(t)-(NT-4); if(jb_>=0)cmask(P0,P1,jb_,qrel,hi);}while(0)
  #define ENDW(tt) do{ if((tt)+3<NT){WAIT_BAR(2);} else if((tt)+2<NT){WAIT_BAR(1);} else {WAIT_BAR(0);} }while(0)
  for(;t+1<NT;t+=2){
    STEP(pB0,pB1,pA0,pA1,t,(t+3<NT),(t+1<NT),(t+1<NT));       ENDW(t);   RESC(); ROT();
    STEP(pA0,pA1,pB0,pB1,t+1,(t+4<NT),(t+2<NT),(t+2<NT));     ENDW(t+1); RESC(); ROT();
  }
  STEP(pB0,pB1,pA0,pA1,NT-1,false,false,false); RESC();
  { float sacc=pB0[0]+pB0[1]; _Pragma("unroll") for(int r=2;r<16;++r)sacc+=pB0[r]; _Pragma("unroll") for(int r=0;r<16;++r)sacc+=pB1[r]; l_reg+=sacc;
    pw0=(u32x4){PKW(pB0,0),PKW(pB0,2),PKW(pB0,4),PKW(pB0,6)};pw1=(u32x4){PKW(pB0,8),PKW(pB0,10),PKW(pB0,12),PKW(pB0,14)};pw2=(u32x4){PKW(pB1,0),PKW(pB1,2),PKW(pB1,4),PKW(pB1,6)};pw3=(u32x4){PKW(pB1,8),PKW(pB1,10),PKW(pB1,12),PKW(pB1,14)};
    SBAR(); pv(o,vb0+sl_cur,PAF(0),PAF(1),PAF(2),PAF(3)); }
  #undef PKW
  #undef PAF
  #undef VFR
  #undef PIN
  #undef MX3
  #undef GAPA
  #undef GAPB
  #undef EX
  #undef VRD
  #undef KRD
  #undef STEP
  #undef ENDW
  {auto rr=__builtin_amdgcn_permlane32_swap(__float_as_uint(l_reg),__float_as_uint(l_reg),false,false);l_reg=__uint_as_float(rr[0])+__uint_as_float(rr[1]);}
  if(hi==0)wsf[32+r32]=l_reg;asm volatile("s_waitcnt lgkmcnt(0)":::"memory");
  float rli[16];
  #pragma unroll
  for(int r=0;r<16;++r)rli[r]=__builtin_amdgcn_rcpf(wsf[32+crow(r,hi)]);
  bf16*Ow=Oh+(long)(q0+wid*QBLK)*OP;
  { bf16*stg=(bf16*)(shm+LDS_OST)+wid*2048;
    #pragma unroll
    for(int r=0;r<16;++r){const int orow=crow(r,hi);
      #pragma unroll
      for(int d0=0;d0<2;++d0)stg[orow*64+d0*32+r32]=(bf16)(o[d0][r]*rli[r]);}
    asm volatile("s_waitcnt lgkmcnt(0)":::"memory");
    #pragma unroll
    for(int i=0;i<4;++i){const int row=i*8+(lane>>3),ch=lane&7; const u32x4 v=*(const u32x4*)(stg+row*64+ch*8); ATTN_STORE16(Ow+(long)row*OP+ch*8,v);} }
  asm volatile("s_waitcnt lgkmcnt(0)\n\ts_barrier":::"memory");
  #undef DMA_K
  #undef DMA_V
  #undef CMASK
  #undef START
  #undef RESC
  #undef ROT
}
constexpr int ATTN_LDS_BYTES=LDS_BYTES;
#undef SBAR
#undef WAIT_BAR
}
constexpr int NWAVES = 8;
#ifndef MK_N_LAUNCHES
#define MK_N_LAUNCHES 1
#endif

constexpr int M = 16384, D = 1024, FF = 2816, NUP = 2 * FF, HD = 64;
constexpr float NORM_EPS = 1e-6f;
constexpr float C2 = 0.125f * 1.4426950408889634f;
constexpr float LAM_INIT = 0.2f;
typedef _Float16 f16;

constexpr size_t MiB = 1u << 20;
constexpr size_t WS_CTL = 0, CTL_ZERO_BYTES = 1 * MiB;
constexpr size_t WS_ROPE = 1 * MiB;
constexpr size_t WS_KMEAN = 5 * MiB;
constexpr size_t WS_W = 6 * MiB;
constexpr size_t W_IN_SZ = (size_t)NUP * D * 2, W_OUT_SZ = (size_t)D * FF * 2, W_SQ = (size_t)D * D * 2;
constexpr size_t WS_WIN = WS_W, WS_WOUT = WS_WIN + 4 * W_IN_SZ, WS_WQKV = WS_WOUT + 4 * W_OUT_SZ, WS_WOD = WS_WQKV + 3 * W_SQ, WS_WKV = WS_WOD + W_SQ, WS_WQM = WS_WKV + 2 * W_SQ, WS_WOM = WS_WQM + W_SQ;
static_assert(WS_WOM + W_SQ == 88 * MiB, "weights end at 88 MiB");
constexpr size_t ACT = (size_t)M * D * 2;
constexpr size_t WS_A1 = 88 * MiB;
constexpr size_t WS_XN = 216 * MiB;
constexpr size_t WS_Y = 152 * MiB;
constexpr size_t WS_A4 = 248 * MiB;
constexpr size_t WS_END = 336 * MiB;
constexpr size_t WS_MPART = 152 * MiB, WS_MML = 280 * MiB, WS_MLIST = 288 * MiB, WS_MQ = 304 * MiB;
static_assert(WS_MPART + (size_t)M * 16 * 4 * 64 * 2 <= WS_MML && WS_MML + (size_t)M * 16 * 4 * 2 * 4 <= WS_MLIST && WS_MLIST + (size_t)16 * 256 * 2016 * 2 <= WS_MQ && WS_MQ + ACT <= WS_END, "moba map");
static_assert(WS_A4 + (size_t)M * FF * 2 <= WS_END, "d_ws map");
constexpr int CW_TMO = 0, CW_CODE = 1, CW_BAR = 4096, CW_MCNT = 8192;

constexpr int RING_OFF = 0, RING_BYTES = 131072;
constexpr int LDSCTL_OFF = RING_BYTES, MISC_OFF = LDSCTL_OFF + 320;
constexpr int LDS_BYTES = 147456;
static_assert(MISC_OFF + 128 <= LDS_BYTES, "LDS map");

#define GAS __attribute__((address_space(1)))
#define LAS __attribute__((address_space(3)))
typedef unsigned v4u __attribute__((ext_vector_type(4)));
typedef unsigned v2u __attribute__((ext_vector_type(2)));
typedef float f32x4 __attribute__((ext_vector_type(4)));
typedef float f32x2 __attribute__((ext_vector_type(2)));
typedef _Float16 h8 __attribute__((ext_vector_type(8)));
typedef _Float16 h2 __attribute__((ext_vector_type(2)));
typedef GAS unsigned gu32;
#define RLX_AGENT __ATOMIC_RELAXED, __HIP_MEMORY_SCOPE_AGENT
#define LDS_WAIT() asm volatile("s_waitcnt lgkmcnt(0)" ::: "memory")
#define VM_WAIT() asm volatile("s_waitcnt vmcnt(0)" ::: "memory")
__device__ __forceinline__ unsigned pk2h(float lo, float hi) { const f32x2 v = {lo, hi}; return __builtin_bit_cast(unsigned, __builtin_convertvector(v, h2)); }

#define XB_TMO      128
#define XB_XCNT(j)  (256  + 64 * (j))
#define XB_XSUB(j)  (1280 + 64 * (j))
#define XB_XGEN(j)  (2304 + 64 * (j))
#define XB_TOP      3328
#define XB_TOPGEN   3392
#define XCD_BAR_WORDS 3456
#define XB_SPIN_CAP (1u << 18)

__device__ __forceinline__ unsigned xb_ld(unsigned* p)              { return __hip_atomic_load(p, __ATOMIC_RELAXED, __HIP_MEMORY_SCOPE_AGENT); }
__device__ __forceinline__ unsigned xb_add(unsigned* p, unsigned v) { return __hip_atomic_fetch_add(p, v, __ATOMIC_RELAXED, __HIP_MEMORY_SCOPE_AGENT); }
__device__ __forceinline__ unsigned xb_xcc_id() { return (unsigned)__builtin_amdgcn_s_getreg((3 << 11) | 20) & 0xFu; }
#define XB_SPIN(cond, bar) do { unsigned _sp = 0; while (cond) { __builtin_amdgcn_s_sleep(1); \
    if ((++_sp & 255u) == 0u) { if (xb_ld(&(bar)[XB_TMO])) break; if (_sp > XB_SPIN_CAP) { atomicAdd(&(bar)[XB_TMO], 1u); break; } } } } while (0)

struct XcdBarrier {
    unsigned* bar; unsigned x;
    volatile LAS unsigned* st;
};

__device__ __forceinline__ XcdBarrier xcd_barrier_post(unsigned* bar, volatile LAS unsigned* st) {
    XcdBarrier b; b.bar = bar; b.x = xb_xcc_id(); b.st = st;
    if (threadIdx.x == 0) (void)xb_add(&bar[XB_XCNT(b.x)], 1u);
    return b;
}
__device__ __forceinline__ void xcd_barrier_complete(unsigned* bar, unsigned x, unsigned& nloc, unsigned& nx) {
    const unsigned G = gridDim.x * gridDim.y * gridDim.z;
    unsigned sum, cnt, mine, sp = 0u;
    for (;;) {
        sum = 0u; cnt = 0u; mine = 0u;
#pragma unroll
        for (unsigned j = 0; j < 16; ++j) { const unsigned c = xb_ld(&bar[XB_XCNT(j)]); sum += c; cnt += (c > 0u) ? 1u : 0u; mine = (j == x) ? c : mine; }
        if (sum == G) break;
        __builtin_amdgcn_s_sleep(1);
        if ((++sp & 255u) == 0u) { if (xb_ld(&bar[XB_TMO])) break; if (sp > XB_SPIN_CAP) { atomicAdd(&bar[XB_TMO], 1u); break; } }
    }
    nloc = mine > 0u ? mine : 1u; nx = cnt > 0u ? cnt : 1u;
}

__device__ __forceinline__ void xcd_barrier(const XcdBarrier& b) {
    asm volatile("s_waitcnt vmcnt(0)" ::: "memory");
    __syncthreads();
    if (threadIdx.x == 0) {
        unsigned* bar = b.bar;
        __builtin_amdgcn_s_waitcnt(0);
        unsigned nloc = b.st[0], nx = b.st[1];
        if (nloc == 0u) { xcd_barrier_complete(bar, b.x, nloc, nx); b.st[0] = nloc; b.st[1] = nx; }
        const unsigned old = xb_add(&bar[XB_XSUB(b.x)], 1u);
        const unsigned gen = old / nloc;
        if (old + 1u == (gen + 1u) * nloc) {
            __builtin_amdgcn_fence(__ATOMIC_RELEASE, "agent");
            asm volatile("s_waitcnt vmcnt(0)" ::: "memory");
            const unsigned og = xb_add(&bar[XB_TOP], 1u);
            const unsigned tg = og / nx;
            if (og + 1u == (tg + 1u) * nx) xb_add(&bar[XB_TOPGEN], 1u);
            else XB_SPIN(xb_ld(&bar[XB_TOPGEN]) == tg, bar);
            __builtin_amdgcn_fence(__ATOMIC_ACQUIRE, "agent");
            xb_add(&bar[XB_XGEN(b.x)], 1u);
            asm volatile("s_waitcnt vmcnt(0)" ::: "memory");
        } else {
            XB_SPIN(xb_ld(&bar[XB_XGEN(b.x)]) == gen, bar);
            __builtin_amdgcn_fence(__ATOMIC_ACQUIRE, "agent");
            asm volatile("s_waitcnt vmcnt(0)" ::: "memory");
        }
    }
    __syncthreads();
}

struct Frame {
    LAS unsigned char* lds;
    volatile LAS unsigned* MISC;
    gu32* ctl;
    int tid, lane, wave;
    int vcu, G;
};
__device__ __forceinline__ float wave_sum(float v) {
#pragma unroll
    for (int o = 1; o < 64; o <<= 1) v += __shfl_xor(v, o);
    return v;
}
__device__ __forceinline__ float wave_max(float v) {
#pragma unroll
    for (int o = 1; o < 64; o <<= 1) v = fmaxf(v, __shfl_xor(v, o));
    return v;
}
__device__ __forceinline__ int wmap(int mode, int n) {
    if (mode == 0) return n;
    if (mode == 1) { const int isup = n >= FF ? 1 : 0, g = isup ? n - FF : n; return 8 * (g >> 2) + 4 * isup + (g & 3); }
    if (n < mode) { const int h = n >> 6, d = n & 63; return (h << 6) + 2 * (d & 31) + (d >> 5); }
    return n;
}
__device__ __forceinline__ void p0_transpose_item(const float* W, int K, int N, f16* WT, int mode, const float* gain, LAS float* scr, int item, int lane) {
    const int nblk = N / 32, kb = item / nblk, nb = item % nblk, k0 = 64 * kb, n0 = 32 * nb;
#pragma unroll 8
    for (int i = 0; i < 32; ++i) { const int kk = 2 * i + (lane >> 5); const float gk = gain ? gain[k0 + kk] : 1.0f; scr[kk * 33 + (lane & 31)] = W[(size_t)(k0 + kk) * N + n0 + (lane & 31)] * gk; }
    LDS_WAIT(); asm volatile("" ::: "memory");
    const int c = lane & 7;
#pragma unroll
    for (int j = 0; j < 4; ++j) { const int n = (lane >> 3) + 8 * j; const LAS float* s = scr + (8 * c) * 33 + n;
        v4u o; o.x = pk2h(s[0 * 33], s[1 * 33]); o.y = pk2h(s[2 * 33], s[3 * 33]); o.z = pk2h(s[4 * 33], s[5 * 33]); o.w = pk2h(s[6 * 33], s[7 * 33]);
        *(GAS v4u*)(WT + (size_t)wmap(mode, n0 + n) * K + k0 + 8 * c) = o; }
    LDS_WAIT(); asm volatile("" ::: "memory");
}
__device__ const float ROPE_INV_FREQ[32] = {
    1.000000000e+00f, 7.498942018e-01f, 5.623413324e-01f, 4.216965139e-01f, 3.162277639e-01f, 2.371373922e-01f, 1.778279394e-01f, 1.333521456e-01f,
    1.000000015e-01f, 7.498941571e-02f, 5.623412877e-02f, 4.216964915e-02f, 3.162277862e-02f, 2.371373586e-02f, 1.778279431e-02f, 1.333521493e-02f,
    9.999999776e-03f, 7.498942316e-03f, 5.623413250e-03f, 4.216964822e-03f, 3.162277862e-03f, 2.371373819e-03f, 1.778279431e-03f, 1.333521446e-03f,
    1.000000047e-03f, 7.498941850e-04f, 5.623413017e-04f, 4.216965463e-04f, 3.162277862e-04f, 2.371373848e-04f, 1.778279402e-04f, 1.333521504e-04f };
__device__ __forceinline__ void rope_entry(int pos, int i, float& c, float& s) {
    const float angf = (float)pos * ROPE_INV_FREQ[i];
    const double a = (double)angf;
    const double kd = __builtin_rint(a * 0.63661977236758134308);
    double t = __builtin_fma(-kd, 1.57079632679489655800e+00, a); t = __builtin_fma(-kd, 6.12323399573676603587e-17, t);
    const double t2 = t * t;
    double sp = -7.6471637318198164759e-13;
    sp = sp * t2 + 1.6059043836821614599e-10;
    sp = sp * t2 - 2.5052108385441718775e-08;
    sp = sp * t2 + 2.7557319223985890653e-06;
    sp = sp * t2 - 1.9841269841269841270e-04;
    sp = sp * t2 + 8.3333333333333333333e-03;
    sp = sp * t2 - 1.6666666666666666667e-01;
    const double sn = t + t * t2 * sp;
    double cp = 4.7794773323873852974e-14;
    cp = cp * t2 - 1.1470745597729724714e-11;
    cp = cp * t2 + 2.0876756987868098979e-09;
    cp = cp * t2 - 2.7557319223985890653e-07;
    cp = cp * t2 + 2.4801587301587301587e-05;
    cp = cp * t2 - 1.3888888888888888889e-03;
    cp = cp * t2 + 4.1666666666666666667e-02;
    cp = cp * t2 - 0.5;
    const double cs = 1.0 + t2 * cp;
    const int q = (int)((long long)kd & 3);
    const double sv = (q == 0) ? sn : (q == 1) ? cs : (q == 2) ? -sn : -cs;
    const double cv = (q == 0) ? cs : (q == 1) ? -sn : (q == 2) ? -cs : sn;
    c = (float)cv; s = (float)sv;
}
__device__ __forceinline__ void rms_rows(Frame& F, const float* x, f16* XN) {
    const int gw = F.vcu * NWAVES + F.wave, NGW = F.G * NWAVES;
    for (int m = gw; m < M; m += NGW) {
        const GAS f32x4* xr = (const GAS f32x4*)(x + (size_t)m * D) + F.lane;
        f32x4 v[4]; float s = 0.f;
#pragma unroll
        for (int j = 0; j < 4; ++j) { v[j] = xr[64 * j]; s += (v[j].x * v[j].x + v[j].y * v[j].y) + (v[j].z * v[j].z + v[j].w * v[j].w); }
        const float r = 1.0f / sqrtf(wave_sum(s) * (1.0f / D) + NORM_EPS);
        GAS v2u* o8 = (GAS v2u*)(XN + (size_t)m * D) + F.lane;
#pragma unroll
        for (int j = 0; j < 4; ++j) { v2u w; w.x = pk2h(v[j].x * r, v[j].y * r); w.y = pk2h(v[j].z * r, v[j].w * r); o8[64 * j] = w; }
    }
}
__device__ __forceinline__ void norm_phase(Frame& F, const float* xin, const float* Y, const float* g, float alpha, float* xout, f16* XN) {
    const int gw = F.vcu * NWAVES + F.wave, NGW = F.G * NWAVES;
    f32x4 gv[4];
#pragma unroll
    for (int j = 0; j < 4; ++j) gv[j] = ((const GAS f32x4*)g)[F.lane + 64 * j] * alpha;
    for (int m = gw; m < M; m += NGW) {
        const GAS f32x4* yr = (const GAS f32x4*)(Y + (size_t)m * D) + F.lane;
        const GAS f32x4* xr = (const GAS f32x4*)(xin + (size_t)m * D) + F.lane;
        f32x4 y[4], x[4]; float s = 0.f;
#pragma unroll
        for (int j = 0; j < 4; ++j) { y[j] = yr[64 * j]; x[j] = xr[64 * j]; s += (y[j].x * y[j].x + y[j].y * y[j].y) + (y[j].z * y[j].z + y[j].w * y[j].w); }
        const float ry = 1.0f / sqrtf(wave_sum(s) * (1.0f / D) + NORM_EPS);
        float s2 = 0.f;
#pragma unroll
        for (int j = 0; j < 4; ++j) { x[j] = x[j] + (y[j] * ry) * gv[j]; s2 += (x[j].x * x[j].x + x[j].y * x[j].y) + (x[j].z * x[j].z + x[j].w * x[j].w); }
        GAS f32x4* xo = (GAS f32x4*)(xout + (size_t)m * D) + F.lane;
#pragma unroll
        for (int j = 0; j < 4; ++j) xo[64 * j] = x[j];
        if (XN) {
            const float r = 1.0f / sqrtf(wave_sum(s2) * (1.0f / D) + NORM_EPS);
            GAS v2u* o8 = (GAS v2u*)(XN + (size_t)m * D) + F.lane;
#pragma unroll
            for (int j = 0; j < 4; ++j) { v2u w; w.x = pk2h(x[j].x * r, x[j].y * r); w.y = pk2h(x[j].z * r, x[j].w * r); o8[64 * j] = w; }
        }
    }
}
__device__ __forceinline__ void p0_prologue(Frame& F, const float* const* in, unsigned char* ws) {
    LAS float* scr = (LAS float*)(F.lds + RING_OFF + F.wave * 16384);
    const int gw = F.vcu * NWAVES + F.wave, NGW = F.G * NWAVES;
    const float* ffn_norm = in[1]; const float* w_in = in[2]; const float* w_out = in[3]; const float* mix_norm = in[4];
    constexpr int I_IN = (D / 64) * (NUP / 32), I_OUT = (FF / 64) * (D / 32), I_SQ = (D / 64) * (D / 32);
    constexpr int NITEMS = 4 * I_IN + 4 * I_OUT + 3 * I_SQ + I_SQ + 2 * I_SQ + I_SQ + I_SQ;
    for (int it = gw; it < NITEMS; it += NGW) {
        int r = it;
        if (r < 4 * I_IN) { const int f = r / I_IN; r -= f * I_IN; p0_transpose_item(w_in + (size_t)f * D * NUP, D, NUP, (f16*)(ws + WS_WIN + f * W_IN_SZ), 1, ffn_norm + (f * 2 + 0) * D, scr, r, F.lane); continue; } r -= 4 * I_IN;
        if (r < 4 * I_OUT) { const int f = r / I_OUT; r -= f * I_OUT; p0_transpose_item(w_out + (size_t)f * FF * D, FF, D, (f16*)(ws + WS_WOUT + f * W_OUT_SZ), 0, nullptr, scr, r, F.lane); continue; } r -= 4 * I_OUT;
        if (r < 3 * I_SQ) { p0_transpose_item(in[5], D, 3 * D, (f16*)(ws + WS_WQKV), 2 * D, mix_norm + 0 * D, scr, r, F.lane); continue; } r -= 3 * I_SQ;
        if (r < I_SQ) { p0_transpose_item(in[8], D, D, (f16*)(ws + WS_WOD), 0, nullptr, scr, r, F.lane); continue; } r -= I_SQ;
        if (r < 2 * I_SQ) { p0_transpose_item(in[10], D, 2 * D, (f16*)(ws + WS_WKV), D, in[9], scr, r, F.lane); continue; } r -= 2 * I_SQ;
        if (r < I_SQ) { p0_transpose_item(in[11], D, D, (f16*)(ws + WS_WQM), D, mix_norm + 2 * D, scr, r, F.lane); continue; } r -= I_SQ;
        p0_transpose_item(in[12], D, D, (f16*)(ws + WS_WOM), 0, nullptr, scr, r, F.lane);
    }
    {
        GAS f32x2* tab = (GAS f32x2*)(ws + WS_ROPE);
        for (int idx = (F.vcu * NWAVES + F.wave) * 64 + F.lane; idx < M * 32; idx += F.G * NWAVES * 64) { float c, s; rope_entry(idx >> 5, idx & 31, c, s); tab[idx] = (f32x2){c, s}; }
    }
    rms_rows(F, in[0], (f16*)(ws + WS_XN));
}
__device__ __forceinline__ void diff_combine(Frame& F, const f16* O2, const float* lamv, const float* subln, f16* A) {
    const int gw = F.vcu * NWAVES + F.wave, NGW = F.G * NWAVES;
    const float s1 = wave_sum(lamv[F.lane] * lamv[64 + F.lane]), s2 = wave_sum(lamv[128 + F.lane] * lamv[192 + F.lane]);
    const float lam = expf(s1) - expf(s2) + LAM_INIT;
    const int h = F.lane >> 3, d0 = (F.lane & 7) * 16;
    float sub[16];
#pragma unroll
    for (int e = 0; e < 16; ++e) sub[e] = subln[d0 + e] * (1.0f - LAM_INIT);
    for (int m = gw; m < M; m += NGW) {
        const GAS h8* p1 = (const GAS h8*)(O2 + (size_t)m * 2048 + (2 * h) * 128 + d0);
        const GAS h8* p2 = (const GAS h8*)(O2 + (size_t)m * 2048 + (2 * h + 1) * 128 + d0);
        const h8 a0 = p1[0], a1 = p1[1], b0 = p2[0], b1 = p2[1];
        float dl[16]; float ss = 0.f;
#pragma unroll
        for (int e = 0; e < 8; ++e) { dl[e] = (float)a0[e] - lam * (float)b0[e]; dl[8 + e] = (float)a1[e] - lam * (float)b1[e]; }
#pragma unroll
        for (int e = 0; e < 16; ++e) ss += dl[e] * dl[e];
        ss += __shfl_xor(ss, 1); ss += __shfl_xor(ss, 2); ss += __shfl_xor(ss, 4);
        const float r = 1.0f / sqrtf(ss * (1.0f / 128.0f) + NORM_EPS);
        v4u w0, w1;
        w0.x = pk2h(dl[0] * r * sub[0], dl[1] * r * sub[1]); w0.y = pk2h(dl[2] * r * sub[2], dl[3] * r * sub[3]); w0.z = pk2h(dl[4] * r * sub[4], dl[5] * r * sub[5]); w0.w = pk2h(dl[6] * r * sub[6], dl[7] * r * sub[7]);
        w1.x = pk2h(dl[8] * r * sub[8], dl[9] * r * sub[9]); w1.y = pk2h(dl[10] * r * sub[10], dl[11] * r * sub[11]); w1.z = pk2h(dl[12] * r * sub[12], dl[13] * r * sub[13]); w1.w = pk2h(dl[14] * r * sub[14], dl[15] * r * sub[15]);
        GAS v4u* o = (GAS v4u*)(A + (size_t)m * D + h * 128 + d0); o[0] = w0; o[1] = w1;
    }
}
__device__ __forceinline__ void kmean_phase(Frame& F, const f16* K, f16* kmean16) {
    const int gw = F.vcu * NWAVES + F.wave, NGW = F.G * NWAVES;
    for (int unit = gw; unit < 64 * 16; unit += NGW) { const int blk = unit >> 4, h = unit & 15;
        const f16* p = K + (size_t)(blk * 256) * D + h * 64 + F.lane; float s = 0.f;
#pragma unroll 8
        for (int r = 0; r < 256; ++r) s += (float)p[(size_t)r * D];
        kmean16[(h * 64 + blk) * 64 + F.lane] = (f16)(s * (1.0f / 256.0f)); }
}
namespace moba {
using attn_body::bf16x8; using attn_body::f32x16; using attn_body::u32x4; using attn_body::crow;
constexpr int L_KV = 0, L_WS = 65536, L_OST = L_WS + 2048, L_IDX = L_OST + 32768, L_PRE = L_IDX + 1024, L_WSUM = L_PRE + 4112, L_END = L_WSUM + 64;
static_assert(L_END <= 131072, "moba LDS");
constexpr int G_CNT = 0, G_BASE = 256, G_LIST = 512, G_END = G_LIST + 64 * 256 * 2;
__host__ __device__ __forceinline__ int list_base(int h, int j) { return h * (256 * 2016) + 256 * (63 * j - (j * (j - 1)) / 2); }
__device__ __forceinline__ bool better(float v, int i, float t, int it) { return v > t || (v == t && i < it); }
__device__ __forceinline__ void ins3(float v, int i, float& t0, int& i0, float& t1, int& i1, float& t2, int& i2) {
    const bool b0 = better(v, i, t0, i0), b1 = better(v, i, t1, i1), b2 = better(v, i, t2, i2);
    const float n2 = b1 ? t1 : (b2 ? v : t2); const int m2 = b1 ? i1 : (b2 ? i : i2);
    const float n1 = b0 ? t0 : (b1 ? v : t1); const int m1 = b0 ? i0 : (b1 ? i : i1);
    const float n0 = b0 ? v : t0; const int m0 = b0 ? i : i0;
    t0 = n0; i0 = m0; t1 = n1; i1 = m1; t2 = n2; i2 = m2;
}
__device__ __forceinline__ void gate_phase(int vcu, int G, const f16* Q, const f16* kmean16, unsigned* gcnt, unsigned short* glist, char* shm) {
    int tid_ = threadIdx.x; asm volatile("" : "+v"(tid_)); const int tid = tid_, lane = tid & 63, r32 = lane & 31, hi = lane >> 5; const int wid = __builtin_amdgcn_readfirstlane(tid >> 6);
    int* lcnt = (int*)(shm + G_CNT); int* lbase = (int*)(shm + G_BASE); unsigned short* llist = (unsigned short*)(shm + G_LIST);
    for (int unit = vcu; unit < 1024; unit += G) {
        const int h = unit & 15, b = 63 - (unit >> 4);
        if (tid < 64) lcnt[tid] = 0;
        __syncthreads();
        if (b > 0) {
            const f16* Qw = Q + (size_t)(b * 256 + wid * 32 + r32) * D + h * 64 + hi * 8;
            const f16* Km = kmean16 + (size_t)(h * 64 + r32) * 64 + hi * 8;
            f32x16 p0 = {}, p1 = {};
#pragma unroll
            for (int d0 = 0; d0 < 4; ++d0) { const bf16x8 qf = *(const bf16x8*)(Qw + d0 * 16); const bf16x8 k0 = *(const bf16x8*)(Km + d0 * 16), k1 = *(const bf16x8*)(Km + 32 * 64 + d0 * 16);
                p0 = attn_body::MF16(k0, qf, p0, 0, 0, 0); p1 = attn_body::MF16(k1, qf, p1, 0, 0, 0); }
            float t0 = -INFINITY, t1 = -INFINITY, t2 = -INFINITY; int i0 = 1 << 20, i1 = 1 << 20, i2 = 1 << 20;
#pragma unroll
            for (int r = 0; r < 16; ++r) { const int blk = crow(r, hi); if (blk < b) ins3(p0[r], blk, t0, i0, t1, i1, t2, i2); }
#pragma unroll
            for (int r = 0; r < 16; ++r) { const int blk = 32 + crow(r, hi); if (blk < b) ins3(p1[r], blk, t0, i0, t1, i1, t2, i2); }
            {
                const float u0 = __shfl_xor(t0, 32), u1 = __shfl_xor(t1, 32), u2 = __shfl_xor(t2, 32); const int j0 = __shfl_xor(i0, 32), j1 = __shfl_xor(i1, 32), j2 = __shfl_xor(i2, 32);
                ins3(u0, j0, t0, i0, t1, i1, t2, i2); ins3(u1, j1, t0, i0, t1, i1, t2, i2); ins3(u2, j2, t0, i0, t1, i1, t2, i2); }
            if (hi == 0) { const int ql = wid * 32 + r32;
                if (i0 < b) { const int pos = __hip_atomic_fetch_add(lcnt + i0, 1, __ATOMIC_RELAXED, __HIP_MEMORY_SCOPE_WORKGROUP); llist[i0 * 256 + pos] = (unsigned short)(ql | (0 << 8)); }
                if (i1 < b) { const int pos = __hip_atomic_fetch_add(lcnt + i1, 1, __ATOMIC_RELAXED, __HIP_MEMORY_SCOPE_WORKGROUP); llist[i1 * 256 + pos] = (unsigned short)(ql | (1 << 8)); }
                if (i2 < b) { const int pos = __hip_atomic_fetch_add(lcnt + i2, 1, __ATOMIC_RELAXED, __HIP_MEMORY_SCOPE_WORKGROUP); llist[i2 * 256 + pos] = (unsigned short)(ql | (2 << 8)); } }
        }
        __syncthreads();
        if (tid < 64) { const int c = lcnt[tid]; lbase[tid] = c > 0 ? (int)__hip_atomic_fetch_add(gcnt + h * 64 + tid, (unsigned)c, __ATOMIC_RELAXED, __HIP_MEMORY_SCOPE_AGENT) : 0; }
        __syncthreads();
        for (int e = tid; e < 64 * 256; e += 512) { const int j = e >> 8, i = e & 255;
            if (i < lcnt[j]) { const unsigned ent = llist[e]; glist[(size_t)list_base(h, j) + lbase[j] + i] = (unsigned short)((b * 256 + (ent & 255u)) | ((ent >> 8) << 14)); } }
        __syncthreads();
    }
}
__device__ __forceinline__ void attn_unit(bool own, int h, int kblk, int nq, const unsigned short* list, int qbase, const f16* Q, const f16* K, const f16* V, f16* Opart, float* ML, char* shm) {
    int tid_ = threadIdx.x; asm volatile("" : "+v"(tid_)); const int tid = tid_, lane = tid & 63, r32 = lane & 31, hi = lane >> 5; const int wid = __builtin_amdgcn_readfirstlane(tid >> 6);
    const unsigned lds0 = (unsigned)(uintptr_t)shm;
    {
        const f16* Kh = K + (size_t)(kblk * 256) * D + h * 64; const f16* Vh = V + (size_t)(kblk * 256) * D + h * 64;
#pragma unroll
        for (int t = 0; t < 4; ++t) {
            attn_body::glds16(Kh + (size_t)(t * 64 + lane) * D + wid * 8, (unsigned)__builtin_amdgcn_readfirstlane(lds0 + L_KV + t * 8192 + wid * 1024));
            attn_body::glds16(Vh + (size_t)(t * 64 + 16 * (wid & 3) + (lane >> 2)) * D + (wid >> 2) * 32 + (lane & 3) * 8, (unsigned)__builtin_amdgcn_readfirstlane(lds0 + L_KV + 32768 + t * 8192 + wid * 1024)); }
    }
    const int e = wid * 32 + r32; const bool act = e < nq; const bool wact = wid * 32 < nq;
    int qi, slot;
    if (own) { qi = qbase + e; slot = 3; } else { const unsigned ent = list[act ? e : (nq - 1)]; qi = (int)(ent & 0x3fffu); slot = (int)(ent >> 14); }
    const int oidx = (qi * 16 + h) * 4 + slot;
    int* widx = (int*)(shm + L_IDX) + wid * 32; float* wsf = (float*)(shm + L_WS) + wid * 64;
    if (hi == 0) widx[r32] = act ? oidx : -1;
    bf16x8 qr[4];
#pragma unroll
    for (int d0 = 0; d0 < 4; ++d0) qr[d0] = *(const bf16x8*)(Q + (size_t)qi * D + h * 64 + d0 * 16 + hi * 8);
    asm volatile("s_waitcnt vmcnt(0) lgkmcnt(0)\n\ts_barrier" ::: "memory");
    if (wact) {
        const int ntile = own ? ((wid >> 1) + 1) : 4; const int qrel = wid * 32 + r32;
        float mx = -INFINITY;
        { const f32x16 zero = {};
          for (int t = 0; t < ntile; ++t) { f32x16 p0, p1; attn_body::qkt(p0, p1, shm + L_KV + t * 8192, qr, zero, r32, hi); asm volatile("s_nop 15\n\ts_nop 7" : "+v"(p0), "+v"(p1));
              if (own) attn_body::cmask(p0, p1, t, qrel, hi);
              mx = fmaxf(mx, attn_body::rowmax(p0, p1)); } }
        f32x16 negm;
#pragma unroll
        for (int r = 0; r < 16; ++r) negm[r] = -mx;
        float l = 0.f; f32x16 o[2]; o[0] = f32x16{}; o[1] = f32x16{};
        const int vb0 = (int)(lds0 + L_KV + 32768) + ((lane >> 4) & 1) * 32 + (lane & 3) * 8 + (4 * hi + ((lane & 15) >> 2)) * 64;
        for (int t = 0; t < ntile; ++t) { f32x16 p0, p1; attn_body::qkt(p0, p1, shm + L_KV + t * 8192, qr, negm, r32, hi); asm volatile("s_nop 15\n\ts_nop 7" : "+v"(p0), "+v"(p1));
            if (own) attn_body::cmask(p0, p1, t, qrel, hi);
            float sacc = 0.f;
#pragma unroll
            for (int r = 0; r < 16; ++r) { p0[r] = __builtin_amdgcn_exp2f(p0[r]); p1[r] = __builtin_amdgcn_exp2f(p1[r]); sacc += p0[r] + p1[r]; }
            l += sacc;
            u32x4 pw0, pw1, pw2, pw3;
#define PKW(P, B) attn_body::cvtpk_s(P[B], P[(B) + 1])
            pw0 = (u32x4){PKW(p0, 0), PKW(p0, 2), PKW(p0, 4), PKW(p0, 6)}; pw1 = (u32x4){PKW(p0, 8), PKW(p0, 10), PKW(p0, 12), PKW(p0, 14)};
            pw2 = (u32x4){PKW(p1, 0), PKW(p1, 2), PKW(p1, 4), PKW(p1, 6)}; pw3 = (u32x4){PKW(p1, 8), PKW(p1, 10), PKW(p1, 12), PKW(p1, 14)};
#undef PKW
            __builtin_amdgcn_sched_barrier(0);
            attn_body::pv(o, vb0 + t * 8192, __builtin_bit_cast(bf16x8, pw0), __builtin_bit_cast(bf16x8, pw1), __builtin_bit_cast(bf16x8, pw2), __builtin_bit_cast(bf16x8, pw3)); }
        { auto rr = __builtin_amdgcn_permlane32_swap(__float_as_uint(l), __float_as_uint(l), false, false); l = __uint_as_float(rr[0]) + __uint_as_float(rr[1]); }
        if (hi == 0) { wsf[32 + r32] = l; if (act) { *(f32x2*)(ML + (size_t)oidx * 2) = (f32x2){mx, l}; } }
        asm volatile("s_waitcnt lgkmcnt(0)" ::: "memory");
        float rli[16];
#pragma unroll
        for (int r = 0; r < 16; ++r) rli[r] = __builtin_amdgcn_rcpf(wsf[32 + crow(r, hi)]);
        f16* stg = (f16*)(shm + L_OST) + wid * 2048;
#pragma unroll
        for (int r = 0; r < 16; ++r) { const int orow = crow(r, hi);
#pragma unroll
            for (int d0 = 0; d0 < 2; ++d0) stg[orow * 64 + d0 * 32 + r32] = (f16)(o[d0][r] * rli[r]); }
        asm volatile("s_waitcnt lgkmcnt(0)" ::: "memory");
#pragma unroll
        for (int i = 0; i < 4; ++i) { const int row = i * 8 + (lane >> 3), ch = lane & 7; const u32x4 v = *(const u32x4*)(stg + row * 64 + ch * 8); const int ix = widx[row];
            if (ix >= 0) *(u32x4*)(Opart + (size_t)ix * 64 + ch * 8) = v; }
    }
    asm volatile("s_waitcnt lgkmcnt(0)\n\ts_barrier" ::: "memory");
}
__device__ __forceinline__ void attn_phase(int vcu, int G, const f16* Q, const f16* K, const f16* V, const unsigned* gcnt, const unsigned short* glist, f16* Opart, float* ML, char* shm) {
    int tid_ = threadIdx.x; asm volatile("" : "+v"(tid_)); const int tid = tid_, lane = tid & 63; const int wid = __builtin_amdgcn_readfirstlane(tid >> 6);
    int* pre = (int*)(shm + L_PRE); int* wsum = (int*)(shm + L_WSUM);
    {
        const int c0 = (int)((gcnt[2 * tid] + 255u) >> 8), c1 = (int)((gcnt[2 * tid + 1] + 255u) >> 8); const int s = c0 + c1; int incl = s;
#pragma unroll
        for (int o = 1; o < 64; o <<= 1) { const int v = __shfl_up(incl, o); if (lane >= o) incl += v; }
        if (lane == 63) wsum[wid] = incl;
        __syncthreads();
        int woff = 0;
        for (int w = 0; w < wid; ++w) woff += wsum[w];
        const int excl = woff + incl - s;
        pre[2 * tid] = excl; pre[2 * tid + 1] = excl + c0; if (tid == 511) pre[1024] = excl + s;
        __syncthreads();
    }
    const int U = pre[1024];
    for (int u = vcu; u < 1024 + U; u += G) {
        if (u < 1024) { const int h = u & 15, b = 63 - (u >> 4); attn_unit(true, h, b, 256, nullptr, b * 256, Q, K, V, Opart, ML, shm); }
        else { const int uu = u - 1024; int lo = 0, hi = 1023;
            while (lo < hi) { const int mid = (lo + hi + 1) >> 1; if (pre[mid] <= uu) lo = mid; else hi = mid - 1; }
            const int p = lo, chunk = uu - pre[p], h = p >> 6, j = p & 63; const int cnt = (int)gcnt[p]; const int nq = (cnt - chunk * 256) < 256 ? (cnt - chunk * 256) : 256;
            attn_unit(false, h, j, nq, glist + (size_t)list_base(h, j) + chunk * 256, 0, Q, K, V, Opart, ML, shm); }
    }
}
__device__ __forceinline__ void combine_phase(int gw, int NGW, int lane, const f16* Opart, const float* ML, f16* O) {
    const int h = lane >> 2, d0 = (lane & 3) * 16;
    for (int q = gw; q < M; q += NGW) {
        const int nsel = (q >> 8) < 3 ? (q >> 8) : 3; const size_t base = ((size_t)q * 16 + h) * 4;
        float m[4], l[4]; float mm = -INFINITY;
#pragma unroll
        for (int s = 0; s < 4; ++s) { const bool v = (s == 3) || (s < nsel); f32x2 ml = v ? *(const f32x2*)(ML + (base + s) * 2) : (f32x2){-INFINITY, 0.f}; m[s] = ml.x; l[s] = ml.y; mm = fmaxf(mm, m[s]); }
        float w[4], L = 0.f;
#pragma unroll
        for (int s = 0; s < 4; ++s) { w[s] = l[s] * __builtin_amdgcn_exp2f(m[s] - mm); L += w[s]; }
        const float rL = 1.0f / L; float acc[16];
#pragma unroll
        for (int e = 0; e < 16; ++e) acc[e] = 0.f;
#pragma unroll
        for (int s = 0; s < 4; ++s) { const bool v = (s == 3) || (s < nsel);
            if (v) { const h8* p = (const h8*)(Opart + (base + s) * 64 + d0); const h8 a = p[0], c = p[1]; const float ws_ = w[s] * rL;
#pragma unroll
                for (int e = 0; e < 8; ++e) { acc[e] += ws_ * (float)a[e]; acc[8 + e] += ws_ * (float)c[e]; } } }
        v4u o0, o1;
        o0.x = pk2h(acc[0], acc[1]); o0.y = pk2h(acc[2], acc[3]); o0.z = pk2h(acc[4], acc[5]); o0.w = pk2h(acc[6], acc[7]);
        o1.x = pk2h(acc[8], acc[9]); o1.y = pk2h(acc[10], acc[11]); o1.z = pk2h(acc[12], acc[13]); o1.w = pk2h(acc[14], acc[15]);
        v4u* op = (v4u*)(O + (size_t)q * D + h * 64 + d0); op[0] = o0; op[1] = o1;
    }
}
}
struct AttnOrder {
    int vcu, G;
    __device__ __forceinline__ bool next(int i, int& head, int& qb) const {
        if (G == 256) { if (i >= 8) return false; const int s = vcu & 7, k = i >> 1; head = vcu >> 3; qb = (i & 1) ? (16 * k + 15 - s) : (16 * k + s); return true; }
        const int uix = i * G + vcu; if (uix >= 2048) return false; head = uix >> 6; qb = 63 - (uix & 63); return true;
    }
};

constexpr int NPHASE = 26;
struct Args { const float* in[13]; float* out; unsigned char* ws; int ph_lo, ph_hi; };
static_assert(sizeof(Args) == 15 * 8 + 8, "Args has no padding");
__global__ void __launch_bounds__(NWAVES * 64, 2) yoco_fwd(Args args) {
    extern __shared__ __attribute__((aligned(16))) unsigned char lds[];
    Frame F;
    F.lds = (LAS unsigned char*)lds;
    F.MISC = (volatile LAS unsigned*)(F.lds + MISC_OFF);
    F.tid = threadIdx.x; F.lane = F.tid & 63; F.wave = __builtin_amdgcn_readfirstlane(F.tid >> 6);
    F.G = gridDim.x; { const int bx = blockIdx.x; F.vcu = (F.G % 8 == 0) ? (bx % 8) * (F.G / 8) + bx / 8 : bx; }
    unsigned char* ws = args.ws;
    F.ctl = (gu32*)(ws + WS_CTL);
    for (int u = F.tid; u < (LDS_BYTES - LDSCTL_OFF) / 4; u += NWAVES * 64) ((LAS unsigned*)(F.lds + LDSCTL_OFF))[u] = 0u;
    __syncthreads();
    const int lo = args.ph_lo, hi = args.ph_hi;
    const bool one_launch = (hi - lo) > 1;
    XcdBarrier bar; bar.bar = (unsigned*)(F.ctl + CW_BAR); bar.x = 0; bar.st = nullptr;
    if (one_launch) bar = xcd_barrier_post((unsigned*)(F.ctl + CW_BAR), F.MISC + 8);
#define IN(k) (lo <= (k) && (k) < hi)
#define SEAM(k) do { if (IN(k) && IN((k) + 1)) xcd_barrier(bar); } while (0)

    const float* x_in = args.in[0]; const float* ffn_norm = args.in[1]; const float* mix_norm = args.in[4];
    float* X = args.out;
    f16* XN = (f16*)(ws + WS_XN); float* Y = (float*)(ws + WS_Y); f16* HB = (f16*)(ws + WS_A4);
    const float* rope = (const float*)(ws + WS_ROPE); f16* kmean16 = (f16*)(ws + WS_KMEAN);
    f16* A1a = (f16*)(ws + WS_A1); f16* A1b = (f16*)(ws + WS_A1 + ACT);
    typedef pg8::bf16_t hb;

#define FFN_PHASES(P, f, XIN, WANT_XN) \
    if (IN(P)) { pg8::Gemm g{(const hb*)XN, (const hb*)(ws + WS_WIN + (size_t)(f) * W_IN_SZ), M, NUP, D}; pg8::StaticOrder S; S.init(M, NUP, F.G, (int)blockIdx.x); \
        pg8::EpiSwiglu E{(hb*)HB, FF}; pg8::gemm_phase<pg8::EpiSwiglu, pg8::StaticOrder, true, true>(F.lds + RING_OFF, g, S, E); } SEAM(P); \
    if (IN((P) + 1)) { pg8::Gemm g{(const hb*)HB, (const hb*)(ws + WS_WOUT + (size_t)(f) * W_OUT_SZ), M, D, FF}; pg8::StaticOrder S; S.init(M, D, F.G, (int)blockIdx.x); \
        pg8::EpiF32 E{Y, D}; pg8::gemm_phase<pg8::EpiF32, pg8::StaticOrder, true, true>(F.lds + RING_OFF, g, S, E); } SEAM((P) + 1); \
    if (IN((P) + 2)) { norm_phase(F, (XIN), Y, ffn_norm + ((f) * 2 + 1) * D, 0.5f, X, (WANT_XN) ? XN : nullptr); } SEAM((P) + 2);

    if (IN(0)) { p0_prologue(F, args.in, ws); } SEAM(0);
    FFN_PHASES(1, 0, x_in, true)
    if (IN(4)) {
        pg8::Gemm g{(const hb*)XN, (const hb*)(ws + WS_WQKV), M, 3 * D, D}; pg8::StaticOrder S; S.init(M, 3 * D, F.G, (int)blockIdx.x);
        pg8::EpiRope3 E{(hb*)A1a, (size_t)M * D, 3u, C2, rope, D};
        pg8::gemm_phase<pg8::EpiRope3, pg8::StaticOrder, true, true>(F.lds + RING_OFF, g, S, E); } SEAM(4);
    if (IN(5)) {
        const AttnOrder S{F.vcu, F.G}; int head, qb;
        const f16* Qp = A1a; const f16* Kp = A1b; const f16* Vp = (const f16*)(ws + WS_Y); f16* O2 = (f16*)(ws + WS_A4);
        for (int i = 0; S.next(i, head, qb); ++i) { const int j = head >> 1, c = head & 1;
            attn_body::attn_unit<8, 2048>(qb, Qp + j * 64, Kp + j * 64, Vp + (j >> 1) * 128 + c * 64, O2 + j * 128 + c * 64, (char*)lds + RING_OFF); } } SEAM(5);
    if (IN(6)) { diff_combine(F, (const f16*)(ws + WS_A4), args.in[6], args.in[7], A1a); } SEAM(6);
    if (IN(7)) { pg8::Gemm g{(const hb*)A1a, (const hb*)(ws + WS_WOD), M, D, D}; pg8::StaticOrder S; S.init(M, D, F.G, (int)blockIdx.x);
        pg8::EpiF32 E{Y, D}; pg8::gemm_phase<pg8::EpiF32, pg8::StaticOrder, true, true>(F.lds + RING_OFF, g, S, E); } SEAM(7);
    if (IN(8)) { norm_phase(F, X, Y, mix_norm + 1 * D, 1.0f, X, XN); } SEAM(8);
    FFN_PHASES(9, 1, X, true)
    if (IN(12)) {
        pg8::Gemm g{(const hb*)XN, (const hb*)(ws + WS_WKV), M, 2 * D, D}; pg8::StaticOrder S; S.init(M, 2 * D, F.G, (int)blockIdx.x);
        pg8::EpiRope3 E{(hb*)A1a, (size_t)M * D, 1u, 1.0f, rope, D};
        pg8::gemm_phase<pg8::EpiRope3, pg8::StaticOrder, true, true>(F.lds + RING_OFF, g, S, E); } SEAM(12);
    if (IN(13)) { kmean_phase(F, A1a, kmean16); } SEAM(13);
    FFN_PHASES(14, 2, X, true)
    if (IN(17)) {
        pg8::Gemm g{(const hb*)XN, (const hb*)(ws + WS_WQM), M, D, D}; pg8::StaticOrder S; S.init(M, D, F.G, (int)blockIdx.x);
        pg8::EpiRope3 E{(hb*)(ws + WS_MQ), (size_t)0, 1u, C2, rope, D};
        pg8::gemm_phase<pg8::EpiRope3, pg8::StaticOrder, true, true>(F.lds + RING_OFF, g, S, E); } SEAM(17);
    if (IN(18)) { moba::gate_phase(F.vcu, F.G, (const f16*)(ws + WS_MQ), kmean16, (unsigned*)(F.ctl + CW_MCNT), (unsigned short*)(ws + WS_MLIST), (char*)lds + RING_OFF); } SEAM(18);
    if (IN(19)) { moba::attn_phase(F.vcu, F.G, (const f16*)(ws + WS_MQ), A1a, A1b, (const unsigned*)(F.ctl + CW_MCNT), (const unsigned short*)(ws + WS_MLIST), (f16*)(ws + WS_MPART), (float*)(ws + WS_MML), (char*)lds + RING_OFF); } SEAM(19);
    if (IN(20)) { moba::combine_phase(F.vcu * NWAVES + F.wave, F.G * NWAVES, F.lane, (const f16*)(ws + WS_MPART), (const float*)(ws + WS_MML), (f16*)(ws + WS_MQ)); } SEAM(20);
    if (IN(21)) { pg8::Gemm g{(const hb*)(ws + WS_MQ), (const hb*)(ws + WS_WOM), M, D, D}; pg8::StaticOrder S; S.init(M, D, F.G, (int)blockIdx.x);
        pg8::EpiF32 E{Y, D}; pg8::gemm_phase<pg8::EpiF32, pg8::StaticOrder, true, true>(F.lds + RING_OFF, g, S, E); } SEAM(21);
    if (IN(22)) { norm_phase(F, X, Y, mix_norm + 3 * D, 1.0f, X, XN); } SEAM(22);
    FFN_PHASES(23, 3, X, false)
#undef FFN_PHASES
#undef IN
#undef SEAM
}

extern "C" void kernel_launch(void* const* d_in, const int* in_sizes, int n_in, void* d_out, int out_size, void* d_ws, size_t ws_size, hipStream_t stream) {
    static int grid = 0;
    if (grid == 0) {
        if (n_in != 13 || in_sizes[0] != M * D || out_size != M * D || ws_size < WS_END) { fprintf(stderr, "kernel_launch: unexpected shapes / workspace (n_in %d, in0 %d, out %d, ws %zu < %zu); nothing launched\n", n_in, n_in > 0 ? in_sizes[0] : -1, out_size, ws_size, (size_t)WS_END); grid = -1; return; }
        int dev = 0, cus = 0, per_cu = 0;
        if (hipGetDevice(&dev) != hipSuccess || hipDeviceGetAttribute(&cus, hipDeviceAttributeMultiprocessorCount, dev) != hipSuccess) { grid = -1; return; }
        if (hipFuncSetAttribute((const void*)yoco_fwd, hipFuncAttributeMaxDynamicSharedMemorySize, LDS_BYTES) != hipSuccess) { fprintf(stderr, "kernel_launch: hipFuncSetAttribute failed\n"); grid = -1; return; }
        if (hipOccupancyMaxActiveBlocksPerMultiprocessor(&per_cu, (const void*)yoco_fwd, NWAVES * 64, LDS_BYTES) != hipSuccess || per_cu < 1) fprintf(stderr, "kernel_launch: occupancy query reports %d workgroups per CU\n", per_cu);
        (void)hipGetLastError();
        grid = cus;
    }
    if (grid < 0) return;
    if (hipMemsetAsync((char*)d_ws + WS_CTL, 0, CTL_ZERO_BYTES, stream) != hipSuccess) return;
    Args a{};
    for (int i = 0; i < 13; ++i) a.in[i] = (const float*)d_in[i];
    a.out = (float*)d_out; a.ws = (unsigned char*)d_ws;
#if MK_N_LAUNCHES == 1
    a.ph_lo = 0; a.ph_hi = NPHASE;
    hipLaunchKernelGGL(yoco_fwd, dim3(grid), dim3(NWAVES * 64), LDS_BYTES, stream, a);
#else
    for (int p = 0; p < NPHASE; ++p) { a.ph_lo = p; a.ph_hi = p + 1; hipLaunchKernelGGL(yoco_fwd, dim3(grid), dim3(NWAVES * 64), LDS_BYTES, stream, a); }
#endif
}
```
